# Optimizing an MI355X kernel written in HIP

```python
import jax, jax.numpy as jnp
from jax import lax
import numpy as np

D_MODEL = 2048
BATCH = 2
SEQ = 4096
DEPTH = 1
DEC_BATCH = 32
DEC_SEQ = 32
PAST_LEN = 4096

CHUNK = 64
Q_BLOCK = 128
H_A = 8
DK_A = 128
DV_A = 128
W_A = H_A * DK_A
WV_A = H_A * DV_A
H_B = 8
DH_B = 128
W_B = H_B * DH_B
D_FF = 4 * D_MODEL
N_BRANCH = 2
EPS = 1e-6
FOX_FORGET_BIAS = 2.0
IN_SIZES = (W_A, W_A, WV_A, WV_A, W_B, W_B, W_B, H_B, N_BRANCH * D_MODEL)
N_IN = W_A * 2 + WV_A * 2 + W_B * 3 + H_B + N_BRANCH * D_MODEL

kernel_name = 'hgrn2_fox_gated_parallel_streaming_step'


def _in_splits():
    return [int(v) for v in np.cumsum(IN_SIZES)[:-1]]


def rmsnorm(x, g):
    xf = x.astype(jnp.float32)
    y = xf * lax.rsqrt(jnp.mean(xf * xf, axis=-1, keepdims=True) + EPS)
    return (y * g.astype(jnp.float32)).astype(x.dtype)


def _gla_block(S, blk):
    q, k, v, lf = blk
    C = q.shape[1]
    b = jnp.cumsum(lf, axis=1)
    causal = jnp.tril(jnp.ones((C, C), dtype=bool))
    diff = b[:, :, None] - b[:, None, :]
    decay = jnp.exp(jnp.where(causal[None, :, :, None, None], diff, -jnp.inf))
    attn = jnp.einsum('bthd,bshd,btshd->bths', q, k, decay)
    o = (jnp.einsum('bthd,bhde->bthe', q * jnp.exp(b), S)
         + jnp.einsum('bths,bshe->bthe', attn, v))
    b_end = b[:, -1]
    S_new = (jnp.exp(b_end)[..., None] * S
             + jnp.einsum('bshd,bshe->bhde', k * jnp.exp(b_end[:, None] - b), v))
    return S_new, o


def hgrn2_mix(S0, q, k, v, lf):
    B, L = q.shape[0], q.shape[1]
    if L <= CHUNK:
        return _gla_block(S0, (q, k, v, lf))
    n = L // CHUNK
    def blocks(a):
        return jnp.moveaxis(a.reshape((B, n, CHUNK) + a.shape[2:]), 1, 0)
    S_new, o = lax.scan(_gla_block, S0, (blocks(q), blocks(k), blocks(v), blocks(lf)))
    o = jnp.moveaxis(o, 0, 1).reshape((B, L) + o.shape[3:])
    return S_new, o


def fox_attend(q, cq, qpos, k, v, ck, kpos):
    s = jnp.einsum('bthd,bshd->bhts', q, k).astype(jnp.float32) * (DH_B ** -0.5)
    s = s + jnp.moveaxis(cq, 2, 1)[..., None] - jnp.moveaxis(ck, 2, 1)[:, :, None, :]
    mask = kpos[None, :] <= qpos[:, None]
    p = jax.nn.softmax(jnp.where(mask[None, None], s, -jnp.inf), axis=-1)
    return jnp.einsum('bhts,bshd->bthd', p.astype(v.dtype), v)


def fox_prompt(q, k, v, lf):
    B, L = q.shape[0], q.shape[1]
    c = jnp.cumsum(lf, axis=1)
    pos = jnp.arange(L)
    nb = L // Q_BLOCK
    qb = jnp.moveaxis(q.reshape(B, nb, Q_BLOCK, H_B, DH_B), 1, 0)
    cb = jnp.moveaxis(c.reshape(B, nb, Q_BLOCK, H_B), 1, 0)
    pb = pos.reshape(nb, Q_BLOCK)
    o = lax.map(lambda a: fox_attend(a[0], a[1], a[2], k, v, c, pos), (qb, cb, pb))
    return jnp.moveaxis(o, 0, 1).reshape(B, L, H_B, DH_B)


def fox_sample(q, k, v, lf, ck, cv, clf):
    P = ck.shape[1]
    T = q.shape[1]
    k_all = jnp.concatenate([ck, k], axis=1)
    v_all = jnp.concatenate([cv, v], axis=1)
    c_all = jnp.cumsum(jnp.concatenate([clf.astype(jnp.float32), lf], axis=1), axis=1)
    kpos = jnp.arange(P + T)
    return fox_attend(q, c_all[:, P:], P + jnp.arange(T), k_all, v_all, c_all, kpos)


def _layer(x, S0, past, norm1, w_in, b_fox_f, lb, gnorm_a, w_pa, w_pb, w_o, norm2, w1, w2):
    B, L, _ = x.shape
    h = rmsnorm(x, norm1)
    proj = h @ w_in
    a_q, a_f, a_i, a_g, b_q, b_k, b_v, b_fl, gate = jnp.split(proj, _in_splits(), axis=-1)
    fa = lb + (1.0 - lb) * jax.nn.sigmoid(a_f.astype(jnp.float32))
    lf_a = jnp.log(fa).reshape(B, L, H_A, DK_A)
    qa = jax.nn.silu(a_q).reshape(B, L, H_A, DK_A)
    ka = (1.0 - fa).reshape(B, L, H_A, DK_A)
    va = a_i.reshape(B, L, H_A, DV_A)
    S_new, oa = hgrn2_mix(S0, qa, ka, va, lf_a)
    oa = rmsnorm(oa, gnorm_a) * jax.nn.silu(a_g.astype(jnp.float32)).reshape(B, L, H_A, DV_A)
    oa = oa.reshape(B, L, WV_A).astype(x.dtype)
    qb = b_q.reshape(B, L, H_B, DH_B)
    kb = b_k.reshape(B, L, H_B, DH_B)
    vb = b_v.reshape(B, L, H_B, DH_B)
    lf_b = jax.nn.log_sigmoid(b_fl.astype(jnp.float32) + b_fox_f.astype(jnp.float32))
    if past is None:
        ob = fox_prompt(qb, kb, vb, lf_b)
    else:
        ob = fox_sample(qb, kb, vb, lf_b, past[0], past[1], past[2])
    ob = ob.reshape(B, L, W_B).astype(x.dtype)
    g = jax.nn.sigmoid(gate.astype(jnp.float32)).astype(x.dtype)
    g_a, g_b = jnp.split(g, 2, axis=-1)
    merged = g_a * (oa @ w_pa) + g_b * (ob @ w_pb)
    x = x + merged @ w_o
    u = jnp.square(jax.nn.relu(rmsnorm(x, norm2) @ w1))
    x = x + u @ w2
    return x, S_new, kb, vb, lf_b


def setup_inputs(seed: int = 0) -> dict:
    key = jax.random.key(seed)
    ks = jax.random.split(key, 20)
    f32 = jnp.float32
    def nrm(k, shape, scale):
        return jax.random.normal(k, shape, f32) * scale
    return {
        'x_prompt': nrm(ks[0], (BATCH, SEQ, D_MODEL), 1.0),
        'x_sample': nrm(ks[1], (DEC_BATCH, DEC_SEQ, D_MODEL), 1.0),
        'cache_fox_k': nrm(ks[2], (DEPTH, DEC_BATCH, PAST_LEN, H_B, DH_B), 1.0),
        'cache_fox_v': nrm(ks[3], (DEPTH, DEC_BATCH, PAST_LEN, H_B, DH_B), 1.0),
        'cache_fox_logf': jax.nn.log_sigmoid(nrm(ks[4], (DEPTH, DEC_BATCH, PAST_LEN, H_B), 1.0) + FOX_FORGET_BIAS),
        'state_hgrn': nrm(ks[5], (DEPTH, DEC_BATCH, H_A, DK_A, DV_A), 0.5),
        'norm1': 1.0 + nrm(ks[6], (DEPTH, D_MODEL), 0.01),
        'w_in': nrm(ks[7], (DEPTH, D_MODEL, N_IN), D_MODEL ** -0.5),
        'b_fox_f': FOX_FORGET_BIAS + nrm(ks[8], (DEPTH, H_B), 0.1),
        'lb_logits': nrm(ks[9], (DEPTH + 1, W_A), 0.1),
        'gnorm_a': 1.0 + nrm(ks[10], (DEPTH, DV_A), 0.01),
        'w_pa': nrm(ks[11], (DEPTH, WV_A, D_MODEL), WV_A ** -0.5),
        'w_pb': nrm(ks[12], (DEPTH, W_B, D_MODEL), W_B ** -0.5),
        'w_o': nrm(ks[13], (DEPTH, D_MODEL, D_MODEL), D_MODEL ** -0.5),
        'norm2': 1.0 + nrm(ks[14], (DEPTH, D_MODEL), 0.01),
        'w1': nrm(ks[15], (DEPTH, D_MODEL, D_FF), D_MODEL ** -0.5),
        'w2': nrm(ks[16], (DEPTH, D_FF, D_MODEL), D_FF ** -0.5),
        'norm_f': 1.0 + nrm(ks[17], (D_MODEL,), 0.01),
    }


def reference(x_prompt, x_sample, cache_fox_k, cache_fox_v, cache_fox_logf, state_hgrn,
              norm1, w_in, b_fox_f, lb_logits, gnorm_a, w_pa, w_pb, w_o, norm2, w1, w2, norm_f):
    lower = jnp.cumsum(jax.nn.softmax(lb_logits.astype(jnp.float32), axis=0), axis=0)
    xp, xs = x_prompt, x_sample
    kp_l, vp_l, lfp_l, Sp_l, ks_l, vs_l, lfs_l, Ss_l = [], [], [], [], [], [], [], []
    for l in range(DEPTH):
        wts = (norm1[l], w_in[l], b_fox_f[l], lower[l], gnorm_a[l], w_pa[l], w_pb[l],
               w_o[l], norm2[l], w1[l], w2[l])
        S0 = jnp.zeros((xp.shape[0], H_A, DK_A, DV_A), jnp.float32)
        xp, Sp, kp, vp, lfp = _layer(xp, S0, None, *wts)
        xs, Ss, ks, vs, lfs = _layer(xs, state_hgrn[l],
                                     (cache_fox_k[l], cache_fox_v[l], cache_fox_logf[l]), *wts)
        kp_l.append(kp); vp_l.append(vp); lfp_l.append(lfp); Sp_l.append(Sp)
        ks_l.append(ks); vs_l.append(vs); lfs_l.append(lfs); Ss_l.append(Ss)
    y_prompt = rmsnorm(xp, norm_f)
    y_sample = rmsnorm(xs, norm_f)
    return (y_prompt, y_sample,
            jnp.stack(kp_l), jnp.stack(vp_l), jnp.stack(lfp_l), jnp.stack(Sp_l),
            jnp.stack(ks_l), jnp.stack(vs_l), jnp.stack(lfs_l), jnp.stack(Ss_l))
```

```cpp
#include <hip/hip_runtime.h>
#include <cstdio>
#include <cstdint>

constexpr int D_MODEL = 2048, SEQ = 4096, NB_P = 2, NB_S = 32, T_S = 32, PAST = 4096;
constexpr int MP = NB_P * SEQ;
constexpr int MS = NB_S * T_S;
constexpr int MROWS = MP + MS;
constexpr int NH = 8, DH = 128, W1K = 1024;
constexpr int D_FF = 8192;
constexpr int N_IN = 11272;
constexpr int N_INP = 11264;
constexpr int COL_FL = 7168;
constexpr int CHK = 32;
constexpr int NCH = SEQ / CHK;
constexpr int NU_P = NB_P * NH * NCH;
constexpr int NU_S = NB_S * NH;
constexpr int NU = NU_P + NU_S;
constexpr int SKV_S = PAST + T_S;
constexpr float EPS = 1e-6f;
constexpr float LOG2E = 1.4426950408889634f;
constexpr float QSCALE = 0.08838834764831845f * LOG2E;

#define GAS __attribute__((address_space(1)))
#define LAS __attribute__((address_space(3)))
#define DI __device__ __forceinline__
typedef unsigned short bf16;
typedef unsigned char uchar;
typedef short bf16x8 __attribute__((ext_vector_type(8)));
typedef short s16x4 __attribute__((ext_vector_type(4)));
typedef float f32x2 __attribute__((ext_vector_type(2)));
typedef float f32x4 __attribute__((ext_vector_type(4)));
typedef float f32x16 __attribute__((ext_vector_type(16)));
typedef unsigned u32x2 __attribute__((ext_vector_type(2)));
typedef unsigned u32x4 __attribute__((ext_vector_type(4)));
typedef __bf16 nbf2 __attribute__((ext_vector_type(2)));

DI unsigned pk2(float lo, float hi) { f32x2 x = {lo, hi}; nbf2 y = __builtin_convertvector(x, nbf2); return __builtin_bit_cast(unsigned, y); }
DI float bf_lo(unsigned u) { return __uint_as_float(u << 16); }
DI float bf_hi(unsigned u) { return __uint_as_float(u & 0xffff0000u); }
DI float fexp2(float x) { return __builtin_amdgcn_exp2f(x); }
DI float fexp(float x) { return __builtin_amdgcn_exp2f(x * LOG2E); }
DI float frcp(float x) { return __builtin_amdgcn_rcpf(x); }
DI float flog(float x) { return __builtin_amdgcn_logf(x) * 0.6931471805599453f; }
DI float fsigmoid(float x) { return frcp(1.0f + fexp(-x)); }
DI float fsilu(float x) { return x * fsigmoid(x); }
DI float wave_sum(float v) {
#pragma unroll
    for (int o = 1; o < 64; o <<= 1) v += __shfl_xor(v, o);
    return v;
}
#define MFMA32(a, b, c) __builtin_amdgcn_mfma_f32_32x32x16_bf16((a), (b), (c), 0, 0, 0)

DI unsigned off_a(unsigned row, unsigned ch) { return 2048u * (row >> 3) + 512u * (ch >> 2) + 64u * (row & 7u) + 16u * ((ch & 3u) ^ ((row >> 2) & 3u)); }
struct FragAddr { unsigned row_e, row_o, trn0, trn1, trp0, trp1; };
DI FragAddr make_frag_addr(int lane) {
    FragAddr a; const unsigned r = lane & 31, h = lane >> 5, blk = (lane >> 4) & 1, q = (lane & 15) >> 2, p = lane & 3;
    a.row_e = off_a(r, h); a.row_o = off_a(r, 2 + h);
    const unsigned ch = 2 * blk + (p >> 1);
    a.trn0 = off_a(8 * h + q, ch) + 8 * (p & 1); a.trn1 = off_a(8 * h + q + 4, ch) + 8 * (p & 1);
    a.trp0 = off_a(4 * h + q, ch) + 8 * (p & 1); a.trp1 = off_a(4 * h + q + 8, ch) + 8 * (p & 1);
    return a;
}
DI bf16x8 frag_row(LAS uchar* img, const FragAddr& fa, int R0, int s) { return *(LAS bf16x8*)(img + ((s & 1) ? fa.row_o : fa.row_e) + 256 * R0 + 512 * (s >> 1)); }
template <bool PERM> DI bf16x8 frag_tr(LAS uchar* img, const FragAddr& fa, int K0, int c, int ks) {
    const int imm = 256 * K0 + 4096 * ks + 512 * c;
    const s16x4 lo = __builtin_amdgcn_ds_read_tr16_b64_v4i16((LAS s16x4*)(img + (PERM ? fa.trp0 : fa.trn0) + imm));
    const s16x4 hi = __builtin_amdgcn_ds_read_tr16_b64_v4i16((LAS s16x4*)(img + (PERM ? fa.trp1 : fa.trn1) + imm));
    return (bf16x8){lo[0], lo[1], lo[2], lo[3], hi[0], hi[1], hi[2], hi[3]};
}
DI bf16x8 pack_acc(const f32x16& x, int s) {
    u32x4 p;
    p[0] = pk2(x[8 * s + 0], x[8 * s + 1]); p[1] = pk2(x[8 * s + 2], x[8 * s + 3]); p[2] = pk2(x[8 * s + 4], x[8 * s + 5]); p[3] = pk2(x[8 * s + 6], x[8 * s + 7]);
    return __builtin_bit_cast(bf16x8, p);
}

constexpr size_t MiB = 1u << 20;
constexpr size_t WS_CTL = 0, CTL_ZERO_BYTES = 1 * MiB;
constexpr size_t WS_WIN = 2 * MiB;
constexpr size_t WS_WPA = 46 * MiB, WS_WPB = 50 * MiB;
constexpr size_t WS_WO = 54 * MiB;
constexpr size_t WS_W1 = 62 * MiB;
constexpr size_t WS_W2 = 94 * MiB;
constexpr size_t WS_H = 126 * MiB;
constexpr size_t WS_QA = 162 * MiB, WS_VA = 180 * MiB, WS_GA = 198 * MiB, WS_QB = 216 * MiB, WS_KB = 234 * MiB, WS_VB = 252 * MiB;
constexpr size_t WS_LFA = 270 * MiB;
constexpr size_t WS_G = 306 * MiB;
constexpr size_t WS_LFB = 378 * MiB;
constexpr size_t WS_LB = 379 * MiB;
constexpr size_t WS_C2P = 380 * MiB;
constexpr size_t WS_C2S = 381 * MiB;
constexpr size_t WS_DEC = 386 * MiB;
constexpr size_t WS_DS = 388 * MiB;
constexpr size_t WS_SP = 532 * MiB;
constexpr size_t WS_OA = 596 * MiB, WS_OB = 614 * MiB;
constexpr size_t WS_T1 = 632 * MiB;
constexpr size_t WS_MG = 704 * MiB;
constexpr size_t WS_X1 = 740 * MiB;
constexpr size_t WS_U = 812 * MiB;
constexpr size_t WS_END = 956 * MiB;
constexpr int CW_BAR = 4096;
constexpr size_t OUT_Y = 0, OUT_KP = (size_t)MROWS * 2048, OUT_VP = OUT_KP + (size_t)MP * 1024, OUT_LFP = OUT_VP + (size_t)MP * 1024, OUT_SP = OUT_LFP + (size_t)MP * 8,
                 OUT_KS = OUT_SP + (size_t)NB_P * NH * 128 * 128, OUT_VS = OUT_KS + (size_t)MS * 1024, OUT_LFS = OUT_VS + (size_t)MS * 1024, OUT_SS = OUT_LFS + (size_t)MS * 8,
                 OUT_END = OUT_SS + (size_t)NB_S * NH * 128 * 128;
constexpr int NWAVES = 8;
constexpr int RING_OFF = 0, RING_BYTES = 131072;
constexpr int LDSCTL_OFF = RING_BYTES, MISC_OFF = LDSCTL_OFF + 320;
constexpr int SCR_OFF = RING_BYTES + 1024;
constexpr int QIMG_OFF = SCR_OFF + 8192;
constexpr int LDS_BYTES = 163840;

#define RLX_AGENT __ATOMIC_RELAXED, __HIP_MEMORY_SCOPE_AGENT
namespace pg8 {
#define PG8_LAS __attribute__((address_space(3)))
typedef unsigned short bf16_t;
typedef short bf16x8 __attribute__((ext_vector_type(8)));
typedef float f32x4 __attribute__((ext_vector_type(4)));
typedef unsigned u32x4 __attribute__((ext_vector_type(4)));
constexpr int BM = 256, BK = 64, HALF = 128, HTB = HALF * BK * 2  , STAGE_BYTES = 8 * HTB, NXCD = 8, WGM = 8;

__host__ __device__ __forceinline__ int lds_byte(int r, int c) { const int st = (r >> 4) * 2 + (c >> 5), rr = r & 15, cc = c & 31, ob = rr * 64 + cc * 2; return st * 1024 + (ob ^ (((ob >> 9) & 1) << 5)); }
__host__ __device__ __forceinline__ void stage_rc(int b, int& R, int& C) { const int st = b / 1024, sb = b % 1024, swz = sb ^ (((sb >> 9) & 1) << 5); R = (st >> 1) * 16 + swz / 64; C = (st & 1) * 32 + (swz % 64) / 2; }
__host__ __device__ __forceinline__ int perm32(int rho) { const int n = rho >> 4, i = rho & 15; return 8 * (i >> 2) + 4 * n + (i & 3); }

struct Unit { int pm, pn; };
struct Gemm { const bf16_t* A; const bf16_t* Bt; int M, N, K; };

struct StaticOrder {
    int nM, nN, nwg, G, c;
    __host__ __device__ void init(int M, int N, int G_, int c_) { nM = M / BM; nN = N / BM; nwg = nM * nN; G = G_; c = c_; }
    __host__ __device__ bool next(int i, Unit& u) const {
        const long L = (long)i * G + c; if (L >= nwg) return false;
        int wgid = (int)L; { const int q = nwg / NXCD, r = nwg % NXCD, xcd = wgid % NXCD, off = wgid / NXCD; wgid = (xcd < r ? xcd * (q + 1) : r * (q + 1) + (xcd - r) * q) + off; }
        const int nig = WGM * nN, gid = wgid / nig, fm = gid * WGM, gsz = (nM - fm) < WGM ? (nM - fm) : WGM;
        u.pm = fm + ((wgid % nig) % gsz); u.pn = (wgid % nig) / gsz; return true;
    }
    __device__ __forceinline__ void a_ready(const Unit&) const {}
    __device__ __forceinline__ void done(const Unit&) const {}
};


template <class Epi, class Sched, bool ALIGN_EPI = false, bool SP2 = false>
__device__ __forceinline__ void gemm_phase(PG8_LAS unsigned char* lds, const Gemm g, const Sched& S, const Epi& E) {
    const int tid = threadIdx.x, wid = __builtin_amdgcn_readfirstlane(tid >> 6), lane = tid & 63, wr = wid >> 2, wc = wid & 3, fr = lane & 15, fq = lane >> 4;
    const int K = g.K, nt = K / BK;
    unsigned voffA[2], voffB[2];
#pragma unroll
    for (int i = 0; i < 2; ++i) { int R, C; stage_rc(tid * 16 + i * 8192, R, C); const int Rb = Epi::PERM ? ((R & ~31) + perm32(R & 31)) : R;
        voffA[i] = (unsigned)(R * K + C) * 2u; voffB[i] = (unsigned)(Rb * K + C) * 2u; }
    const size_t kstep = (size_t)(BK * 2);
    const size_t hstep = (size_t)HALF * K * 2;
    const size_t tstep = 2 * hstep;
    const unsigned ldsw = (unsigned)wid * 1024u;
    const int aoff = lds_byte(wr * 64 + fr, fq * 8), boff = lds_byte(wc * 32 + fr, fq * 8);
#define PG8_SA(b, h) (((b) * 2 + (h)) * HTB)
#define PG8_SB(b, h) ((4 + (b) * 2 + (h)) * HTB)
#define PG8_STAGE(bufoff, gbase, voff) do { _Pragma("unroll") for (int _i = 0; _i < 2; ++_i) \
        __builtin_amdgcn_global_load_lds((const unsigned*)((const char*)(gbase) + (voff)[_i]), (PG8_LAS unsigned*)(lds + (bufoff) + ldsw + _i * 8192), 16, 0, 0); } while (0)
#define PG8_LDA(dst, b, h) do { _Pragma("unroll") for (int m = 0; m < 4; ++m) _Pragma("unroll") for (int k = 0; k < 2; ++k) dst[m][k] = *(const PG8_LAS bf16x8*)(lds + PG8_SA(b, h) + aoff + m * 2048 + k * 1024); } while (0)
#define PG8_LDB(dst, b, h) do { _Pragma("unroll") for (int n = 0; n < 2; ++n) _Pragma("unroll") for (int k = 0; k < 2; ++k) dst[n][k] = *(const PG8_LAS bf16x8*)(lds + PG8_SB(b, h) + boff + n * 2048 + k * 1024); } while (0)
#define PG8_MMA(ai, bj, At, Bt) do { __builtin_amdgcn_s_setprio(1); _Pragma("unroll") for (int m = 0; m < 4; ++m) _Pragma("unroll") for (int n = 0; n < 2; ++n) _Pragma("unroll") for (int k = 0; k < 2; ++k) \
        acc[ai][bj][m][n] = __builtin_amdgcn_mfma_f32_16x16x32_bf16(Bt[n][k], At[m][k], acc[ai][bj][m][n], 0, 0, 0); __builtin_amdgcn_s_setprio(0); } while (0)
#define PG8_WAIT_V(n) asm volatile("s_waitcnt vmcnt(" #n ")" ::: "memory")
#define PG8_WAIT_L(n) asm volatile("s_waitcnt lgkmcnt(" #n ")" ::: "memory")
#define PG8_BAR __builtin_amdgcn_s_barrier()
#define PG8_SCHED __builtin_amdgcn_sched_barrier(0)
    Unit cur, nxt; int ui = 0;
    if (!S.next(0, cur)) return;
    f32x4 acc[2][2][4][2];
#pragma unroll
    for (int a = 0; a < 2; ++a)
#pragma unroll
        for (int b = 0; b < 2; ++b)
#pragma unroll
            for (int m = 0; m < 4; ++m)
#pragma unroll
                for (int n = 0; n < 2; ++n) acc[a][b][m][n] = (f32x4){0.f, 0.f, 0.f, 0.f};
    bf16x8 At[4][2], B0[2][2], B1[2][2];
    const char* cA = (const char*)g.A + (size_t)cur.pm * tstep; const char* cB = (const char*)g.Bt + (size_t)cur.pn * tstep;
    S.a_ready(cur);
    if constexpr (SP2) {
        PG8_STAGE(PG8_SB(0, 0), cB, voffB); PG8_STAGE(PG8_SB(0, 1), cB + hstep, voffB); PG8_STAGE(PG8_SA(0, 0), cA, voffA); PG8_STAGE(PG8_SA(0, 1), cA + hstep, voffA);
        if (wr == 1) PG8_BAR;
        PG8_WAIT_V(2); PG8_BAR;
        PG8_STAGE(PG8_SB(1, 0), cB + kstep, voffB); PG8_STAGE(PG8_SA(1, 0), cA + kstep, voffA); PG8_STAGE(PG8_SB(1, 1), cB + hstep + kstep, voffB);
        PG8_WAIT_V(6); PG8_BAR;
    } else {
        PG8_STAGE(PG8_SB(0, 0), cB, voffB); PG8_STAGE(PG8_SA(0, 0), cA, voffA); PG8_STAGE(PG8_SB(0, 1), cB + hstep, voffB); PG8_STAGE(PG8_SA(0, 1), cA + hstep, voffA);
        if (wr == 1) PG8_BAR;
        PG8_WAIT_V(4); PG8_BAR;
        PG8_STAGE(PG8_SB(1, 0), cB + kstep, voffB); PG8_STAGE(PG8_SA(1, 0), cA + kstep, voffA); PG8_STAGE(PG8_SB(1, 1), cB + hstep + kstep, voffB);
        PG8_WAIT_V(6); PG8_BAR;
    }
    for (;;) {
        const bool has_next = S.next(ui + 1, nxt);
        const char* nA = has_next ? (const char*)g.A + (size_t)nxt.pm * tstep : cA; const char* nB = has_next ? (const char*)g.Bt + (size_t)nxt.pn * tstep : cB;
        for (int t = 0; t < nt; t += 2) {
            const bool last = (t == nt - 2);
            const char* a1 = cA + (size_t)(t + 1) * kstep;
            const char* a2 = last ? nA : cA + (size_t)(t + 2) * kstep; const char* b2 = last ? nB : cB + (size_t)(t + 2) * kstep;
            const char* a3 = a2 + kstep; const char* b3 = b2 + kstep;
            if (last && has_next) S.a_ready(nxt);
            if constexpr (SP2) {
            PG8_LDB(B0, 0, 0); PG8_LDB(B1, 0, 1); PG8_SCHED; PG8_LDA(At, 0, 0); PG8_STAGE(PG8_SA(1, 1), a1 + hstep, voffA);
            PG8_WAIT_V(8); PG8_WAIT_L(0); PG8_BAR; PG8_MMA(0, 0, At, B0); PG8_MMA(0, 1, At, B1); PG8_BAR; PG8_SCHED;
            PG8_LDA(At, 0, 1); PG8_STAGE(PG8_SB(0, 0), b2, voffB); PG8_STAGE(PG8_SB(0, 1), b2 + hstep, voffB); PG8_STAGE(PG8_SA(0, 0), a2, voffA);
            PG8_WAIT_V(8); PG8_WAIT_L(0); PG8_BAR; PG8_MMA(1, 0, At, B0); PG8_MMA(1, 1, At, B1); PG8_BAR; PG8_SCHED;
            PG8_LDB(B0, 1, 0); PG8_LDB(B1, 1, 1); PG8_SCHED; PG8_LDA(At, 1, 0); PG8_STAGE(PG8_SA(0, 1), a2 + hstep, voffA);
            PG8_WAIT_V(8); PG8_WAIT_L(0); PG8_BAR; PG8_MMA(0, 0, At, B0); PG8_MMA(0, 1, At, B1); PG8_BAR; PG8_SCHED;
            PG8_LDA(At, 1, 1); PG8_STAGE(PG8_SB(1, 0), b3, voffB); PG8_STAGE(PG8_SB(1, 1), b3 + hstep, voffB); PG8_STAGE(PG8_SA(1, 0), a3, voffA);
            PG8_WAIT_V(8); PG8_WAIT_L(0); PG8_BAR; PG8_MMA(1, 0, At, B0); PG8_MMA(1, 1, At, B1); PG8_BAR; PG8_SCHED;
            } else {
            PG8_LDB(B0, 0, 0); PG8_SCHED; PG8_LDA(At, 0, 0); PG8_STAGE(PG8_SA(1, 1), a1 + hstep, voffA);
            PG8_WAIT_L(8); PG8_BAR; PG8_WAIT_L(0); PG8_MMA(0, 0, At, B0); PG8_BAR; PG8_SCHED;
            PG8_LDB(B1, 0, 1); PG8_STAGE(PG8_SB(0, 0), b2, voffB);
            PG8_BAR; PG8_WAIT_L(0); PG8_MMA(0, 1, At, B1); PG8_BAR;
            PG8_LDA(At, 0, 1); PG8_STAGE(PG8_SA(0, 0), a2, voffA);
            PG8_BAR; PG8_WAIT_L(0); PG8_MMA(1, 0, At, B0); PG8_BAR; PG8_SCHED;
            PG8_STAGE(PG8_SB(0, 1), b2 + hstep, voffB);
            PG8_WAIT_V(6); PG8_BAR; PG8_MMA(1, 1, At, B1); PG8_BAR;
            PG8_LDB(B0, 1, 0); PG8_SCHED; PG8_LDA(At, 1, 0); PG8_STAGE(PG8_SA(0, 1), a2 + hstep, voffA);
            PG8_WAIT_L(8); PG8_BAR; PG8_WAIT_L(0); PG8_MMA(0, 0, At, B0); PG8_BAR; PG8_SCHED;
            PG8_LDB(B1, 1, 1); PG8_STAGE(PG8_SB(1, 0), b3, voffB);
            PG8_BAR; PG8_WAIT_L(0); PG8_MMA(0, 1, At, B1); PG8_BAR;
            PG8_LDA(At, 1, 1); PG8_STAGE(PG8_SA(1, 0), a3, voffA);
            PG8_BAR; PG8_WAIT_L(0); PG8_MMA(1, 0, At, B0); PG8_BAR; PG8_SCHED;
            PG8_STAGE(PG8_SB(1, 1), b3 + hstep, voffB);
            PG8_WAIT_V(6); PG8_BAR; PG8_MMA(1, 1, At, B1); PG8_BAR;
            }
        }
        if constexpr (ALIGN_EPI) { if (wr == 0) PG8_BAR; }
        if constexpr (!Epi::AFTER_DRAIN) { E(acc, cur, wr, wc, fr, fq); S.done(cur); }
        if (!has_next) break;
#pragma unroll
        for (int a = 0; a < 2; ++a)
#pragma unroll
            for (int b = 0; b < 2; ++b)
#pragma unroll
                for (int m = 0; m < 4; ++m)
#pragma unroll
                    for (int n = 0; n < 2; ++n) acc[a][b][m][n] = (f32x4){0.f, 0.f, 0.f, 0.f};
        cur = nxt; cA = nA; cB = nB; ++ui;
        if constexpr (ALIGN_EPI) { if (wr == 1) PG8_BAR; }
    }
    PG8_WAIT_V(0);
    if constexpr (!ALIGN_EPI) { if (wr == 0) PG8_BAR; }
    PG8_BAR;
    if constexpr (Epi::AFTER_DRAIN) { E.fused(acc, cur, wr, wc, fr, fq, lds, wid, lane); S.done(cur); }
#undef PG8_SA
#undef PG8_SB
#undef PG8_STAGE
#undef PG8_LDA
#undef PG8_LDB
#undef PG8_MMA
#undef PG8_WAIT_V
#undef PG8_WAIT_L
#undef PG8_BAR
#undef PG8_SCHED
}
}

namespace pg8 {
DI void unpack8(const u32x4 w, float (&f)[8]) { f[0] = bf_lo(w[0]); f[1] = bf_hi(w[0]); f[2] = bf_lo(w[1]); f[3] = bf_hi(w[1]); f[4] = bf_lo(w[2]); f[5] = bf_hi(w[2]); f[6] = bf_lo(w[3]); f[7] = bf_hi(w[3]); }

struct EpiInProj {
    static constexpr bool PERM = true, AFTER_DRAIN = false;
    uchar* ws; float* out;
    DI void operator()(const f32x4 (&acc)[2][2][4][2], const Unit& u0, int wr, int wc, int fr, int fq) const {
        Unit u = u0; asm volatile("" : "+s"(u.pm), "+s"(u.pn));
        { int ln; asm volatile("v_mbcnt_lo_u32_b32 %0, -1, 0\n\tv_mbcnt_hi_u32_b32 %0, -1, %0" : "=v"(ln)); fr = ln & 15; fq = ln >> 4; }
        const int grp = u.pn < 28 ? (u.pn >> 2) : 7;
        const int ld = (grp == 7) ? 4096 : 1024;
        const int cg0 = ((grp == 7) ? (u.pn - 28) : (u.pn & 3)) * BM + wc * 32 + 8 * fq;
        const size_t oboff = grp == 0 ? WS_QA : grp == 1 ? WS_LFA : grp == 2 ? WS_VA : grp == 3 ? WS_GA : grp == 4 ? WS_QB : grp == 5 ? WS_KB : grp == 6 ? WS_VB : WS_G;
        uchar* ob = ws + oboff;
        float* of = out + ((grp == 5) ? ((u.pm < 32) ? OUT_KP : OUT_KS - (size_t)MP * 1024) : ((u.pm < 32) ? OUT_VP : OUT_VS - (size_t)MP * 1024));
        float lb[2][8];
#pragma unroll
        for (int bj = 0; bj < 2; ++bj)
#pragma unroll
            for (int e = 0; e < 8; ++e) lb[bj][e] = 0.f;
        if (grp == 1) { const float* LB = (const float*)(ws + WS_LB);
#pragma unroll
            for (int bj = 0; bj < 2; ++bj) { const f32x4 a = *(const f32x4*)(LB + cg0 + bj * HALF), b = *(const f32x4*)(LB + cg0 + bj * HALF + 4);
                lb[bj][0] = a[0]; lb[bj][1] = a[1]; lb[bj][2] = a[2]; lb[bj][3] = a[3]; lb[bj][4] = b[0]; lb[bj][5] = b[1]; lb[bj][6] = b[2]; lb[bj][7] = b[3]; }
        }
#pragma unroll
        for (int ai = 0; ai < 2; ++ai)
#pragma unroll
            for (int m = 0; m < 4; ++m) {
                const size_t roff = (size_t)(u.pm * BM + wr * 64 + fr + ai * HALF + m * 16) * ld + cg0;
#pragma unroll
                for (int bj = 0; bj < 2; ++bj) {
                    float v[8];
#pragma unroll
                    for (int e = 0; e < 4; ++e) { v[e] = acc[ai][bj][m][0][e]; v[4 + e] = acc[ai][bj][m][1][e]; }
                    if (grp == 5 || grp == 6) { *(f32x4*)(of + roff + bj * HALF) = acc[ai][bj][m][0]; *(f32x4*)(of + roff + bj * HALF + 4) = acc[ai][bj][m][1]; }
                    if (grp == 0 || grp == 3) {
#pragma unroll
                        for (int e = 0; e < 8; ++e) v[e] = fsilu(v[e]);
                    } else if (grp == 1) {
#pragma unroll
                        for (int e = 0; e < 8; ++e) { const float s = fsigmoid(v[e]); v[e] = flog(lb[bj][e] + (1.0f - lb[bj][e]) * s); }
                    } else if (grp == 4) {
#pragma unroll
                        for (int e = 0; e < 8; ++e) v[e] *= QSCALE;
                    } else if (grp == 7) {
#pragma unroll
                        for (int e = 0; e < 8; ++e) v[e] = fsigmoid(v[e]);
                    }
                    if (grp == 1) { float* p = (float*)ob + roff + bj * HALF; *(f32x4*)p = (f32x4){v[0], v[1], v[2], v[3]}; *(f32x4*)(p + 4) = (f32x4){v[4], v[5], v[6], v[7]}; }
                    else { u32x4 w; w[0] = pk2(v[0], v[1]); w[1] = pk2(v[2], v[3]); w[2] = pk2(v[4], v[5]); w[3] = pk2(v[6], v[7]); *(u32x4*)((bf16*)ob + roff + bj * HALF) = w; }
                }
            }
    }
};

template <int MODE> struct EpiMix {
    static constexpr bool PERM = true, AFTER_DRAIN = false;
    const bf16* G; float* T1; bf16* O; int ld;
    DI void operator()(const f32x4 (&acc)[2][2][4][2], const Unit& u, int wr, int wc, int fr, int fq) const {
        const int row0 = u.pm * BM + wr * 64 + fr, col0 = u.pn * BM + wc * 32 + 8 * fq;
#pragma unroll
        for (int ai = 0; ai < 2; ++ai)
#pragma unroll
            for (int m = 0; m < 4; ++m) {
                const int r = row0 + ai * HALF + m * 16;
#pragma unroll
                for (int bj = 0; bj < 2; ++bj) {
                    const int c = col0 + bj * HALF;
                    float v[8];
#pragma unroll
                    for (int e = 0; e < 4; ++e) { v[e] = acc[ai][bj][m][0][e]; v[4 + e] = acc[ai][bj][m][1][e]; }
                    if (MODE == 0) {
                        float g[8]; unpack8(*(const u32x4*)(G + (size_t)r * 4096 + c), g);
                        float* t = T1 + (size_t)r * 2048 + c;
                        *(f32x4*)t = (f32x4){v[0] * g[0], v[1] * g[1], v[2] * g[2], v[3] * g[3]}; *(f32x4*)(t + 4) = (f32x4){v[4] * g[4], v[5] * g[5], v[6] * g[6], v[7] * g[7]};
                    } else if (MODE == 1) {
                        float g[8]; unpack8(*(const u32x4*)(G + (size_t)r * 4096 + 2048 + c), g);
                        const float* t = T1 + (size_t)r * 2048 + c; const f32x4 t0 = *(const f32x4*)t, t1 = *(const f32x4*)(t + 4);
                        u32x4 w; w[0] = pk2(t0[0] + v[0] * g[0], t0[1] + v[1] * g[1]); w[1] = pk2(t0[2] + v[2] * g[2], t0[3] + v[3] * g[3]);
                        w[2] = pk2(t1[0] + v[4] * g[4], t1[1] + v[5] * g[5]); w[3] = pk2(t1[2] + v[6] * g[6], t1[3] + v[7] * g[7]);
                        *(u32x4*)(O + (size_t)r * 2048 + c) = w;
                    } else {
#pragma unroll
                        for (int e = 0; e < 8; ++e) { const float t = fmaxf(v[e], 0.f); v[e] = t * t; }
                        u32x4 w; w[0] = pk2(v[0], v[1]); w[1] = pk2(v[2], v[3]); w[2] = pk2(v[4], v[5]); w[3] = pk2(v[6], v[7]);
                        *(u32x4*)(O + (size_t)r * ld + c) = w;
                    }
                }
            }
    }
};

struct EpiResid {
    static constexpr bool PERM = false, AFTER_DRAIN = false;
    const float* base_p; const float* base_s; float* out;
    DI void operator()(const f32x4 (&acc)[2][2][4][2], const Unit& u, int wr, int wc, int fr, int fq) const {
        const int row0 = u.pm * BM + wr * 64 + fr, col0 = u.pn * BM + wc * 32 + 4 * fq;
        const float* base = (u.pm < 32) ? base_p : base_s;
#pragma unroll
        for (int ai = 0; ai < 2; ++ai)
#pragma unroll
            for (int m = 0; m < 4; ++m) { const size_t off = (size_t)(row0 + ai * HALF + m * 16) * 2048 + col0;
#pragma unroll
                for (int bj = 0; bj < 2; ++bj)
#pragma unroll
                    for (int n = 0; n < 2; ++n) { const f32x4 b = *(const f32x4*)(base + off + bj * HALF + n * 16); *(f32x4*)(out + off + bj * HALF + n * 16) = b + acc[ai][bj][m][n]; } }
    }
};
}
#define XB_TMO      128
#define XB_XCNT(j)  (256  + 64 * (j))
#define XB_XSUB(j)  (1280 + 64 * (j))
#define XB_XGEN(j)  (2304 + 64 * (j))
#define XB_TOP      3328
#define XB_TOPGEN   3392
#define XCD_BAR_WORDS 3456
#define XB_SPIN_CAP (1u << 18)

__device__ __forceinline__ unsigned xb_ld(unsigned* p)              { return __hip_atomic_load(p, __ATOMIC_RELAXED, __HIP_MEMORY_SCOPE_AGENT); }
__device__ __forceinline__ unsigned xb_add(unsigned* p, unsigned v) { return __hip_atomic_fetch_add(p, v, __ATOMIC_RELAXED, __HIP_MEMORY_SCOPE_AGENT); }
__device__ __forceinline__ unsigned xb_xcc_id() { return (unsigned)__builtin_amdgcn_s_getreg((3 << 11) | 20) & 0xFu; }
#define XB_SPIN(cond, bar) do { unsigned _sp = 0; while (cond) { __builtin_amdgcn_s_sleep(1); \
    if ((++_sp & 255u) == 0u) { if (xb_ld(&(bar)[XB_TMO])) break; if (_sp > XB_SPIN_CAP) { atomicAdd(&(bar)[XB_TMO], 1u); break; } } } } while (0)

struct XcdBarrier {
    unsigned* bar; unsigned x;
    volatile LAS unsigned* st;
};

__device__ __forceinline__ XcdBarrier xcd_barrier_post(unsigned* bar, volatile LAS unsigned* st) {
    XcdBarrier b; b.bar = bar; b.x = xb_xcc_id(); b.st = st;
    if (threadIdx.x == 0) (void)xb_add(&bar[XB_XCNT(b.x)], 1u);
    return b;
}
__device__ __forceinline__ void xcd_barrier_complete(unsigned* bar, unsigned x, unsigned& nloc, unsigned& nx) {
    const unsigned G = gridDim.x * gridDim.y * gridDim.z;
    unsigned sum, cnt, mine, sp = 0u;
    for (;;) {
        sum = 0u; cnt = 0u; mine = 0u;
#pragma unroll
        for (unsigned j = 0; j < 16; ++j) { const unsigned c = xb_ld(&bar[XB_XCNT(j)]); sum += c; cnt += (c > 0u) ? 1u : 0u; mine = (j == x) ? c : mine; }
        if (sum == G) break;
        __builtin_amdgcn_s_sleep(1);
        if ((++sp & 255u) == 0u) { if (xb_ld(&bar[XB_TMO])) break; if (sp > XB_SPIN_CAP) { atomicAdd(&bar[XB_TMO], 1u); break; } }
    }
    nloc = mine > 0u ? mine : 1u; nx = cnt > 0u ? cnt : 1u;
}

__device__ __forceinline__ void xcd_barrier(const XcdBarrier& b) {
    asm volatile("s_waitcnt vmcnt(0)" ::: "memory");
    __syncthreads();
    if (threadIdx.x == 0) {
        unsigned* bar = b.bar;
        __builtin_amdgcn_s_waitcnt(0);
        unsigned nloc = b.st[0], nx = b.st[1];
        if (nloc == 0u) { xcd_barrier_complete(bar, b.x, nloc, nx); b.st[0] = nloc; b.st[1] = nx; }
        const unsigned old = xb_add(&bar[XB_XSUB(b.x)], 1u);
        const unsigned gen = old / nloc;
        if (old + 1u == (gen + 1u) * nloc) {
            __builtin_amdgcn_fence(__ATOMIC_RELEASE, "agent");
            asm volatile("s_waitcnt vmcnt(0)" ::: "memory");
            const unsigned og = xb_add(&bar[XB_TOP], 1u);
            const unsigned tg = og / nx;
            if (og + 1u == (tg + 1u) * nx) xb_add(&bar[XB_TOPGEN], 1u);
            else XB_SPIN(xb_ld(&bar[XB_TOPGEN]) == tg, bar);
            __builtin_amdgcn_fence(__ATOMIC_ACQUIRE, "agent");
            xb_add(&bar[XB_XGEN(b.x)], 1u);
            asm volatile("s_waitcnt vmcnt(0)" ::: "memory");
        } else {
            XB_SPIN(xb_ld(&bar[XB_XGEN(b.x)]) == gen, bar);
            __builtin_amdgcn_fence(__ATOMIC_ACQUIRE, "agent");
            asm volatile("s_waitcnt vmcnt(0)" ::: "memory");
        }
    }
    __syncthreads();
}


struct Frame {
    LAS uchar* lds;
    int tid, lane, wave, G, bid;
    const float *x_p, *x_s, *ck, *cv, *clf, *st0, *norm1, *w_in, *b_fox, *lb_logits, *gnorm, *w_pa, *w_pb, *w_o, *norm2, *w1, *w2, *norm_f;
    float* out; uchar* ws;
};
template <class T> DI T* wsp(const Frame& F, size_t off) { return (T*)(F.ws + off); }
DI const float* xrow(const Frame& F, int row) { return row < MP ? F.x_p + (size_t)row * D_MODEL : F.x_s + (size_t)(row - MP) * D_MODEL; }

DI void p0_transpose_item(const float* W, int ldw, int K, bf16* WT, int nblk, int shift_from, int shift, LAS float* scr, int item, int lane) {
    const int kb = item / nblk, nb = item % nblk, k0 = 64 * kb, n0 = 32 * nb, n0s = n0 + (n0 >= shift_from ? shift : 0);
#pragma unroll 8
    for (int i = 0; i < 32; ++i) { const int kk = 2 * i + (lane >> 5); scr[kk * 33 + (lane & 31)] = W[(size_t)(k0 + kk) * ldw + n0s + (lane & 31)]; }
    asm volatile("s_waitcnt lgkmcnt(0)" ::: "memory");
    const int c = lane & 7;
#pragma unroll
    for (int j = 0; j < 4; ++j) { const int n = (lane >> 3) + 8 * j; const LAS float* s = scr + (8 * c) * 33 + n;
        u32x4 o; o[0] = pk2(s[0 * 33], s[1 * 33]); o[1] = pk2(s[2 * 33], s[3 * 33]); o[2] = pk2(s[4 * 33], s[5 * 33]); o[3] = pk2(s[6 * 33], s[7 * 33]);
        *(u32x4*)(WT + (size_t)(n0 + n) * K + k0 + 8 * c) = o; }
    asm volatile("s_waitcnt lgkmcnt(0)" ::: "memory");
}
template <bool WITH_FL> DI void rms_row_bf16(const Frame& F, const float* xr, const float* g, bf16* orow, int row) {
    const f32x4* xv = (const f32x4*)xr + F.lane; const f32x4* gv = (const f32x4*)g + F.lane;
    f32x4 v[8]; float s = 0.f;
#pragma unroll
    for (int j = 0; j < 8; ++j) { v[j] = xv[64 * j]; s += (v[j][0] * v[j][0] + v[j][1] * v[j][1]) + (v[j][2] * v[j][2] + v[j][3] * v[j][3]); }
    const float rstd = 1.0f / sqrtf(wave_sum(s) * (1.0f / D_MODEL) + EPS);
    u32x2* o8 = (u32x2*)orow + F.lane;
    float fl[8];
#pragma unroll
    for (int c = 0; c < 8; ++c) fl[c] = 0.f;
#pragma unroll
    for (int j = 0; j < 8; ++j) {
        const f32x4 gg = gv[64 * j]; const f32x4 h = v[j] * rstd * gg;
        o8[64 * j] = (u32x2){pk2(h[0], h[1]), pk2(h[2], h[3])};
        if (WITH_FL) {
#pragma unroll
            for (int e = 0; e < 4; ++e) { const float* wr = F.w_in + (size_t)(4 * F.lane + 256 * j + e) * N_IN + COL_FL; const f32x4 w0 = *(const f32x4*)wr, w1 = *(const f32x4*)(wr + 4);
                fl[0] += h[e] * w0[0]; fl[1] += h[e] * w0[1]; fl[2] += h[e] * w0[2]; fl[3] += h[e] * w0[3]; fl[4] += h[e] * w1[0]; fl[5] += h[e] * w1[1]; fl[6] += h[e] * w1[2]; fl[7] += h[e] * w1[3]; }
        }
    }
    if (WITH_FL) {
        float mine = 0.f;
#pragma unroll
        for (int c = 0; c < 8; ++c) { const float t = wave_sum(fl[c]); if (F.lane == c) mine = t; }
        if (F.lane < 8) {
            const float z = mine + F.b_fox[F.lane];
            const float ls = fminf(z, 0.f) - log1pf(expf(-fabsf(z)));
            wsp<float>(F, WS_LFB)[(size_t)row * 8 + F.lane] = ls;
            if (row < MP) F.out[OUT_LFP + (size_t)row * 8 + F.lane] = ls; else F.out[OUT_LFS + (size_t)(row - MP) * 8 + F.lane] = ls;
        }
    }
}
DI void p0_prologue(const Frame& F) {
    LAS float* scr = (LAS float*)(F.lds + RING_OFF + F.wave * 16384);
    const int gw = F.bid * NWAVES + F.wave, NGW = F.G * NWAVES;
    { const int gid = F.bid * 512 + F.tid; if (gid < W1K) { const float a = F.lb_logits[gid], b = F.lb_logits[W1K + gid]; wsp<float>(F, WS_LB)[gid] = 1.0f / (1.0f + expf(b - a)); } }
    constexpr int I_IN = (D_MODEL / 64) * (N_INP / 32), I_PA = (W1K / 64) * (D_MODEL / 32), I_O = (D_MODEL / 64) * (D_MODEL / 32), I_1 = (D_MODEL / 64) * (D_FF / 32), I_2 = (D_FF / 64) * (D_MODEL / 32);
    constexpr int NITEMS = I_IN + 2 * I_PA + I_O + I_1 + I_2;
    for (int it = gw; it < NITEMS; it += NGW) {
        int r = it;
        if (r < I_IN) { p0_transpose_item(F.w_in, N_IN, D_MODEL, wsp<bf16>(F, WS_WIN), N_INP / 32, COL_FL, 8, scr, r, F.lane); continue; } r -= I_IN;
        if (r < I_PA) { p0_transpose_item(F.w_pa, D_MODEL, W1K, wsp<bf16>(F, WS_WPA), D_MODEL / 32, 1 << 30, 0, scr, r, F.lane); continue; } r -= I_PA;
        if (r < I_PA) { p0_transpose_item(F.w_pb, D_MODEL, W1K, wsp<bf16>(F, WS_WPB), D_MODEL / 32, 1 << 30, 0, scr, r, F.lane); continue; } r -= I_PA;
        if (r < I_O) { p0_transpose_item(F.w_o, D_MODEL, D_MODEL, wsp<bf16>(F, WS_WO), D_MODEL / 32, 1 << 30, 0, scr, r, F.lane); continue; } r -= I_O;
        if (r < I_1) { p0_transpose_item(F.w1, D_FF, D_MODEL, wsp<bf16>(F, WS_W1), D_FF / 32, 1 << 30, 0, scr, r, F.lane); continue; } r -= I_1;
        p0_transpose_item(F.w2, D_MODEL, D_FF, wsp<bf16>(F, WS_W2), D_MODEL / 32, 1 << 30, 0, scr, r, F.lane);
    }
    for (int m = gw; m < MROWS; m += NGW) rms_row_bf16<true>(F, xrow(F, m), F.norm1, wsp<bf16>(F, WS_H) + (size_t)m * D_MODEL, m);
}

DI void scan_rows(const float* src, int n, float (&carry)[8], float* dst, size_t dstride, int j0, int lane) {
    for (int i0 = 0; i0 < n; i0 += 64) {
        const int j = i0 + lane; const bool ok = j < n;
        float v[8];
        { f32x4 a = {0.f, 0.f, 0.f, 0.f}, b = {0.f, 0.f, 0.f, 0.f}; if (ok) { a = *(const f32x4*)(src + (size_t)j * 8); b = *(const f32x4*)(src + (size_t)j * 8 + 4); }
          v[0] = a[0]; v[1] = a[1]; v[2] = a[2]; v[3] = a[3]; v[4] = b[0]; v[5] = b[1]; v[6] = b[2]; v[7] = b[3]; }
#pragma unroll
        for (int h = 0; h < 8; ++h) {
#pragma unroll
            for (int o = 1; o < 64; o <<= 1) { const float t = __shfl_up(v[h], o); if (lane >= o) v[h] += t; }
            v[h] += carry[h];
            carry[h] = __shfl(v[h], 63);
            if (ok) dst[(size_t)h * dstride + j0 + j] = v[h] * LOG2E;
        }
    }
}
DI void p2_scans(const Frame& F) {
    const int gw = F.bid * NWAVES + F.wave;
    if (gw >= NB_P + NB_S) return;
    float carry[8];
#pragma unroll
    for (int h = 0; h < 8; ++h) carry[h] = 0.f;
    const float* lfb = wsp<float>(F, WS_LFB);
    if (gw < NB_P) { scan_rows(lfb + (size_t)gw * SEQ * 8, SEQ, carry, wsp<float>(F, WS_C2P) + (size_t)gw * 8 * SEQ, SEQ, 0, F.lane); }
    else { const int b = gw - NB_P; float* dst = wsp<float>(F, WS_C2S) + (size_t)b * 8 * SKV_S;
        scan_rows(F.clf + (size_t)b * PAST * 8, PAST, carry, dst, SKV_S, 0, F.lane);
        scan_rows(lfb + (size_t)(MP + b * T_S) * 8, T_S, carry, dst, SKV_S, PAST, F.lane); }
}

DI void unit_rc(int u, int& row0, int& head) { if (u < NU_P) { const int bh = u >> 7, c = u & 127; row0 = (bh >> 3) * SEQ + c * CHK; head = bh & 7; } else { const int su = u - NU_P; row0 = MP + (su >> 3) * T_S; head = su & 7; } }
constexpr int HG_QT = 0, HG_KT = 8192, HG_KP = 16384, HG_V = 24576, HG_SP = 32768;
template <bool WRITE_DEC> DI void hgrn_prep(const Frame& F, int u, int tl, LAS uchar* base) {
    int row0, head; unit_rc(u, row0, head);
    if (tl < 128) {
        const int d = tl;
        const float* lfp = wsp<float>(F, WS_LFA) + (size_t)row0 * W1K + head * DH + d; const bf16* qp = wsp<bf16>(F, WS_QA) + (size_t)row0 * W1K + head * DH + d;
        float lf[CHK], bb[CHK], q[CHK];
#pragma unroll
        for (int t = 0; t < CHK; ++t) { lf[t] = lfp[(size_t)t * W1K]; q[t] = __uint_as_float((unsigned)qp[(size_t)t * W1K] << 16); }
        float b = 0.f;
#pragma unroll
        for (int t = 0; t < CHK; ++t) { b += lf[t]; bb[t] = b; }
        const float bend = b;
#pragma unroll
        for (int t = 0; t < CHK; ++t) {
            const float k = 1.0f - fexp(lf[t]);
            const float qt = q[t] * fexp(bb[t]), kt = k * fexp(-bb[t]), kp = k * fexp(bend - bb[t]);
            const unsigned a = off_a((unsigned)t, (unsigned)(d >> 3)) + (unsigned)(d & 7) * 2u;
            *(LAS unsigned short*)(base + HG_QT + a) = (unsigned short)(pk2(qt, 0.f) & 0xffffu);
            *(LAS unsigned short*)(base + HG_KT + a) = (unsigned short)(pk2(kt, 0.f) & 0xffffu);
            *(LAS unsigned short*)(base + HG_KP + a) = (unsigned short)(pk2(kp, 0.f) & 0xffffu);
        }
        if (WRITE_DEC) wsp<float>(F, WS_DEC)[(size_t)u * DH + d] = fexp(bend);
    } else {
        const int t2 = tl - 128; const bf16* vp = wsp<bf16>(F, WS_VA) + (size_t)row0 * W1K + head * DH;
#pragma unroll
        for (int i = 0; i < 4; ++i) { const int idx = t2 + 128 * i, row = idx >> 4, ch = idx & 15;
            *(LAS u32x4*)(base + HG_V + off_a((unsigned)row, (unsigned)ch)) = *(const u32x4*)(vp + (size_t)row * W1K + ch * 8); }
    }
}
DI void p3_hgrn_local(const Frame& F) {
    const int hw = F.wave >> 2, wl = F.wave & 3, tl = F.tid & 255, lane = F.lane, h = lane >> 5;
    LAS uchar* base = F.lds + RING_OFF + hw * 65536;
    const FragAddr fa = make_frag_addr(lane);
    for (int it = F.bid; it < NU / 2; it += F.G) {
        const int u = 2 * it + hw;
        hgrn_prep<true>(F, u, tl, base);
        __syncthreads();
        float* ds = wsp<float>(F, WS_DS) + (size_t)u * (DH * DH);
        const int dt = wl;
        const bf16x8 a0 = frag_tr<false>(base + HG_KP, fa, 0, dt, 0), a1 = frag_tr<false>(base + HG_KP, fa, 0, dt, 1);
#pragma unroll
        for (int et = 0; et < 4; ++et) {
            f32x16 acc;
#pragma unroll
            for (int i = 0; i < 16; ++i) acc[i] = 0.f;
            acc = MFMA32(a0, frag_tr<false>(base + HG_V, fa, 0, et, 0), acc);
            acc = MFMA32(a1, frag_tr<false>(base + HG_V, fa, 0, et, 1), acc);
#pragma unroll
            for (int i = 0; i < 16; ++i) { const int d = 32 * dt + (i & 3) + 8 * (i >> 2) + 4 * h; ds[(size_t)d * DH + 32 * et + (lane & 31)] = acc[i]; }
        }
        __syncthreads();
    }
}
DI void p4_hgrn_scan(const Frame& F) {
    const int gid = F.bid * 512 + F.tid, NT = F.G * 512;
    const float* DSb = wsp<float>(F, WS_DS); const float* DEC = wsp<float>(F, WS_DEC); bf16* SP = wsp<bf16>(F, WS_SP);
    for (int ch = gid; ch < NB_P * NH * DH * (DH / 2); ch += NT) {
        const int bh = ch >> 13, d = (ch >> 6) & 127, e = (ch & 63) * 2;
        float s0 = 0.f, s1 = 0.f;
        const size_t eo = (size_t)d * DH + e;
#pragma unroll 8
        for (int c = 0; c < NCH; ++c) {
            const int u = bh * NCH + c;
            const f32x2 dv = *(const f32x2*)(DSb + (size_t)u * (DH * DH) + eo); const float dc = DEC[(size_t)u * DH + d];
            *(unsigned*)(SP + (size_t)u * (DH * DH) + eo) = pk2(s0, s1);
            s0 = s0 * dc + dv[0]; s1 = s1 * dc + dv[1];
        }
        *(f32x2*)(F.out + OUT_SP + (size_t)bh * (DH * DH) + eo) = (f32x2){s0, s1};
    }
    for (int i = gid; i < NU_S * DH * DH / 4; i += NT) {
        const int su = i >> 12, r = i & 4095, d = r >> 5;
        const int u = NU_P + su;
        const f32x4 s0 = *(const f32x4*)(F.st0 + (size_t)i * 4), dv = *(const f32x4*)(DSb + (size_t)u * (DH * DH) + (size_t)r * 4); const float dc = DEC[(size_t)u * DH + d];
        *(f32x4*)(F.out + OUT_SS + (size_t)i * 4) = s0 * dc + dv;
    }
}
DI void p5_hgrn_out(const Frame& F) {
    const int hw = F.wave >> 2, wl = F.wave & 3, tl = F.tid & 255, lane = F.lane, h = lane >> 5, t = lane & 31;
    LAS uchar* base = F.lds + RING_OFF + hw * 65536;
    LAS float* red = (LAS float*)(F.lds + SCR_OFF) + hw * 128;
    const FragAddr fa = make_frag_addr(lane);
    for (int it = F.bid; it < NU / 2; it += F.G) {
        const int u = 2 * it + hw;
        int row0, head; unit_rc(u, row0, head);
        hgrn_prep<false>(F, u, tl, base);
        if (u < NU_P) {
            const bf16* sp = wsp<bf16>(F, WS_SP) + (size_t)u * (DH * DH);
#pragma unroll
            for (int i = 0; i < 8; ++i) { const int idx = tl + 256 * i, row = idx >> 4, ch = idx & 15;
                *(LAS u32x4*)(base + HG_SP + off_a((unsigned)row, (unsigned)ch)) = *(const u32x4*)(sp + (size_t)row * DH + ch * 8); }
        } else {
            const float* sp = F.st0 + (size_t)(u - NU_P) * (DH * DH);
#pragma unroll
            for (int i = 0; i < 16; ++i) { const int idx = tl + 256 * i, row = idx >> 5, c4 = idx & 31; const f32x4 v = *(const f32x4*)(sp + (size_t)row * DH + c4 * 4);
                *(LAS u32x2*)(base + HG_SP + off_a((unsigned)row, (unsigned)(c4 >> 1)) + 8 * (c4 & 1)) = (u32x2){pk2(v[0], v[1]), pk2(v[2], v[3])}; }
        }
        __syncthreads();
        const int et = wl;
        bf16x8 qf[8];
#pragma unroll
        for (int ks = 0; ks < 8; ++ks) qf[ks] = frag_row(base + HG_QT, fa, 0, ks);
        f32x16 at, o;
#pragma unroll
        for (int i = 0; i < 16; ++i) { at[i] = 0.f; o[i] = 0.f; }
#pragma unroll
        for (int ks = 0; ks < 8; ++ks) at = MFMA32(frag_row(base + HG_KT, fa, 0, ks), qf[ks], at);
#pragma unroll
        for (int i = 0; i < 16; ++i) { const int s = (i & 3) + 8 * (i >> 2) + 4 * h; at[i] = (s <= t) ? at[i] : 0.f; }
#pragma unroll
        for (int ks = 0; ks < 8; ++ks) o = MFMA32(frag_tr<false>(base + HG_SP, fa, 0, et, ks), qf[ks], o);
        o = MFMA32(frag_tr<true>(base + HG_V, fa, 0, et, 0), pack_acc(at, 0), o);
        o = MFMA32(frag_tr<true>(base + HG_V, fa, 0, et, 1), pack_acc(at, 1), o);
        float ss = 0.f;
#pragma unroll
        for (int i = 0; i < 16; ++i) ss += o[i] * o[i];
        ss += __shfl_xor(ss, 32);
        if (h == 0) red[wl * 32 + t] = ss;
        __syncthreads();
        const float tot = (red[t] + red[32 + t]) + (red[64 + t] + red[96 + t]);
        const float rstd = 1.0f / sqrtf(tot * (1.0f / DH) + EPS);
        const bf16* ga = wsp<bf16>(F, WS_GA) + (size_t)(row0 + t) * W1K + head * DH; bf16* oa = wsp<bf16>(F, WS_OA) + (size_t)(row0 + t) * W1K + head * DH;
#pragma unroll
        for (int g = 0; g < 4; ++g) {
            const int e0 = 32 * et + 8 * g + 4 * h;
            const f32x4 gn = *(const f32x4*)(F.gnorm + e0); const u32x2 gw2 = *(const u32x2*)(ga + e0);
            const float v0 = o[4 * g + 0] * rstd * gn[0] * bf_lo(gw2[0]), v1 = o[4 * g + 1] * rstd * gn[1] * bf_hi(gw2[0]), v2 = o[4 * g + 2] * rstd * gn[2] * bf_lo(gw2[1]), v3 = o[4 * g + 3] * rstd * gn[3] * bf_hi(gw2[1]);
            *(u32x2*)(oa + e0) = (u32x2){pk2(v0, v1), pk2(v2, v3)};
        }
        __syncthreads();
    }
}

template <bool QLDS> DI bool flash_qk(const bool MASK, const bf16x8 (&qf)[8], LAS uchar* qimg, LAS uchar* kimg, int R0, const float* ck2, float cq2, int kabs0, int qabs, float& m, float& l, f32x16 (&o)[4], bf16x8& pf0, bf16x8& pf1, int lane, const FragAddr& fa) {
    const int h = lane >> 5;
    f32x16 s;
#pragma unroll
    for (int i = 0; i < 16; ++i) s[i] = 0.f;
#pragma unroll
    for (int ks = 0; ks < 8; ++ks) s = MFMA32(frag_row(kimg, fa, R0, ks), QLDS ? frag_row(qimg, fa, 0, ks) : qf[ks], s);
    float mx = -INFINITY;
#pragma unroll
    for (int g = 0; g < 4; ++g) {
        const f32x4 ck = *(const f32x4*)(ck2 + 8 * g + 4 * h);
#pragma unroll
        for (int e = 0; e < 4; ++e) {
            float v = s[4 * g + e] + (cq2 - ck[e]);
            if (MASK) { const int key = kabs0 + 8 * g + 4 * h + e; v = (key <= qabs) ? v : -INFINITY; }
            s[4 * g + e] = v; mx = fmaxf(mx, v);
        }
    }
    mx = fmaxf(mx, __shfl_xor(mx, 32));
    if (__all(mx < m - 150.f)) return false;
    if (__any(mx > m)) {
        const float mn = fmaxf(m, mx), alpha = fexp2(m - mn);
        m = mn; l *= alpha;
#pragma unroll
        for (int dt = 0; dt < 4; ++dt) o[dt] = o[dt] * alpha;
    }
    float ps = 0.f;
#pragma unroll
    for (int i = 0; i < 16; ++i) { const float p = fexp2(s[i] - m); s[i] = p; ps += p; }
    l += ps;
    pf0 = pack_acc(s, 0); pf1 = pack_acc(s, 1);
    return true;
}
DI void flash_pv(LAS uchar* vimg, int R0, const bf16x8& pf0, const bf16x8& pf1, f32x16 (&o)[4], const FragAddr& fa) {
#pragma unroll
    for (int dt = 0; dt < 4; ++dt) o[dt] = MFMA32(frag_tr<true>(vimg, fa, R0, dt, 0), pf0, o[dt]);
#pragma unroll
    for (int dt = 0; dt < 4; ++dt) o[dt] = MFMA32(frag_tr<true>(vimg, fa, R0, dt, 1), pf1, o[dt]);
}

DI void attn_prompt_unit(const Frame& F, int bh, int qb) {
    const int lane = F.lane, w = F.wave, wq = w & 3, wk = w >> 2, h = lane >> 5, c = lane & 31, tid = F.tid;
    const int b = bh >> 3, head = bh & 7;
    const FragAddr fa = make_frag_addr(lane);
    const bf16* Qg = wsp<bf16>(F, WS_QB) + (size_t)b * SEQ * W1K + head * DH;
    const bf16* Kg = wsp<bf16>(F, WS_KB) + (size_t)b * SEQ * W1K + head * DH;
    const bf16* Vg = wsp<bf16>(F, WS_VB) + (size_t)b * SEQ * W1K + head * DH;
    const float* c2 = wsp<float>(F, WS_C2P) + (size_t)bh * SEQ;
    const int q0 = qb * 128, qabs = q0 + 32 * wq + c, nit = qb + 1;
    bf16x8 qf[8];
#pragma unroll
    for (int ks = 0; ks < 8; ++ks) qf[ks] = *(const bf16x8*)(Qg + (size_t)qabs * W1K + 16 * ks + 8 * h);
    const float cq2 = c2[qabs];
    float m = -1e30f, l = 0.f; f32x16 o[4];
#pragma unroll
    for (int dt = 0; dt < 4; ++dt)
#pragma unroll
        for (int i = 0; i < 16; ++i) o[dt][i] = 0.f;
    u32x4 kr[4], vr[4];
#define AP_LOAD(itx) do { _Pragma("unroll") for (int i = 0; i < 4; ++i) { const int idx = tid + 512 * i, key = idx >> 4, ch = idx & 15; const size_t go = (size_t)((itx) * 128 + key) * W1K + ch * 8; \
        kr[i] = *(const u32x4*)(Kg + go); vr[i] = *(const u32x4*)(Vg + go); } } while (0)
#define AP_WRITE(sx) do { LAS uchar* sb_ = F.lds + RING_OFF + (sx) * 65536; _Pragma("unroll") for (int i = 0; i < 4; ++i) { const int idx = tid + 512 * i, key = idx >> 4, ch = idx & 15; \
        const unsigned a = (unsigned)(key >> 6) * 16384u + off_a((unsigned)(key & 63), (unsigned)ch); *(LAS u32x4*)(sb_ + a) = kr[i]; *(LAS u32x4*)(sb_ + 32768 + a) = vr[i]; } } while (0)
    AP_LOAD(nit - 1); AP_WRITE((nit - 1) & 1);
    __syncthreads();
    for (int it = nit - 1; it >= 0; --it) {
        const bool more = it > 0;
        if (more) AP_LOAD(it - 1);
        LAS uchar* sb = F.lds + RING_OFF + (it & 1) * 65536;
        LAS uchar* kimg = sb + wk * 16384; LAS uchar* vimg = sb + 32768 + wk * 16384;
        const int kabs0 = it * 128 + wk * 64;
        bf16x8 pf0, pf1;
        const bool diag = (it == nit - 1);
#pragma unroll 1
        for (int R0 = 32; R0 >= 0; R0 -= 32)
            if (flash_qk<false>(diag, qf, nullptr, kimg, R0, c2 + kabs0 + R0, cq2, kabs0 + R0, qabs, m, l, o, pf0, pf1, lane, fa)) flash_pv(vimg, R0, pf0, pf1, o, fa);
        if (more) AP_WRITE((it - 1) & 1);
        __syncthreads();
    }
#undef AP_LOAD
#undef AP_WRITE
    LAS f32x4* xb = (LAS f32x4*)(F.lds + RING_OFF) + wq * (17 * 64);
    if (wk == 1) {
#pragma unroll
        for (int dt = 0; dt < 4; ++dt)
#pragma unroll
            for (int g = 0; g < 4; ++g) xb[(dt * 4 + g) * 64 + lane] = (f32x4){o[dt][4 * g], o[dt][4 * g + 1], o[dt][4 * g + 2], o[dt][4 * g + 3]};
        xb[16 * 64 + lane] = (f32x4){m, l, 0.f, 0.f};
    }
    __syncthreads();
    if (wk == 0) {
        const f32x4 ml = xb[16 * 64 + lane];
        const float mn = fmaxf(m, ml[0]), a0 = fexp2(m - mn), a1 = fexp2(ml[0] - mn);
        float lt = l * a0 + ml[1] * a1;
        lt += __shfl_xor(lt, 32);
        const float inv = 1.0f / lt;
        bf16* og = wsp<bf16>(F, WS_OB) + (size_t)(b * SEQ + qabs) * W1K + head * DH;
#pragma unroll
        for (int dt = 0; dt < 4; ++dt)
#pragma unroll
            for (int g = 0; g < 4; ++g) {
                const f32x4 p = xb[(dt * 4 + g) * 64 + lane];
                const float v0 = (o[dt][4 * g] * a0 + p[0] * a1) * inv, v1 = (o[dt][4 * g + 1] * a0 + p[1] * a1) * inv, v2 = (o[dt][4 * g + 2] * a0 + p[2] * a1) * inv, v3 = (o[dt][4 * g + 3] * a0 + p[3] * a1) * inv;
                *(u32x2*)(og + 32 * dt + 8 * g + 4 * h) = (u32x2){pk2(v0, v1), pk2(v2, v3)};
            }
    }
    __syncthreads();
}
DI void p6_attn_prompt(const Frame& F) {
#pragma unroll 1
    for (int j = 2 * F.bid; j < 2 * NB_P * NH * 16; j += ((j & 1) ? 2 * F.G - 1 : 1)) {
        const int item = j >> 1, bh = item >> 4, p = item & 15;
        attn_prompt_unit(F, bh, (j & 1) ? p : 31 - p);
    }
}

DI void cache_tile_to_image(const float* src, LAS uchar* img, int lrow, int lch) {
    const float* p = src + (size_t)lrow * (NH * DH) + lch * 4;
#pragma unroll
    for (int hf = 0; hf < 2; ++hf) {
        f32x4 r[8];
#pragma unroll
        for (int i = 0; i < 8; ++i) r[i] = __builtin_nontemporal_load((const f32x4*)(p + (size_t)(2 * (8 * hf + i)) * (NH * DH)));
#pragma unroll
        for (int i = 0; i < 8; ++i) { const int row = 2 * (8 * hf + i) + lrow;
            *(LAS u32x2*)(img + off_a((unsigned)row, (unsigned)(lch >> 1)) + 8 * (lch & 1)) = (u32x2){pk2(r[i][0], r[i][1]), pk2(r[i][2], r[i][3])}; }
    }
}
DI void attn_sample_unit(const Frame& F, int su) {
    const int lane = F.lane, w = F.wave, h = lane >> 5, c = lane & 31;
    const int b = su >> 3, head = su & 7;
    const FragAddr fa = make_frag_addr(lane);
    LAS uchar* kimg = F.lds + RING_OFF + w * 16384; LAS uchar* vimg = kimg + 8192;
    const float* c2 = wsp<float>(F, WS_C2S) + (size_t)su * SKV_S;
    const int rowq = MP + b * T_S + c;
    bf16x8 qf[8];
#pragma unroll
    for (int ks = 0; ks < 8; ++ks) qf[ks] = (bf16x8){0, 0, 0, 0, 0, 0, 0, 0};
    LAS uchar* qimg = F.lds + QIMG_OFF;
    { const int row = F.tid >> 4, ch = F.tid & 15;
      *(LAS u32x4*)(qimg + off_a((unsigned)row, (unsigned)ch)) = *(const u32x4*)(wsp<bf16>(F, WS_QB) + (size_t)(MP + b * T_S + row) * W1K + head * DH + ch * 8); }
    __syncthreads();
    const float cq2 = c2[PAST + c];
    float m = -1e30f, l = 0.f; f32x16 o[4];
#pragma unroll
    for (int dt = 0; dt < 4; ++dt)
#pragma unroll
        for (int i = 0; i < 16; ++i) o[dt][i] = 0.f;
    bf16x8 pf0, pf1;
    if (w == 0) {
        const bf16* kg = wsp<bf16>(F, WS_KB) + (size_t)(MP + b * T_S) * W1K + head * DH; const bf16* vg = wsp<bf16>(F, WS_VB) + (size_t)(MP + b * T_S) * W1K + head * DH;
#pragma unroll
        for (int i = 0; i < 8; ++i) { const int idx = lane + 64 * i, row = idx >> 4, ch = idx & 15;
            *(LAS u32x4*)(kimg + off_a((unsigned)row, (unsigned)ch)) = *(const u32x4*)(kg + (size_t)row * W1K + ch * 8);
            *(LAS u32x4*)(vimg + off_a((unsigned)row, (unsigned)ch)) = *(const u32x4*)(vg + (size_t)row * W1K + ch * 8); }
        if (flash_qk<true>(true, qf, qimg, kimg, 0, c2 + PAST, cq2, 0, c, m, l, o, pf0, pf1, lane, fa)) flash_pv(vimg, 0, pf0, pf1, o, fa);
    }
    const float* kb = F.ck + ((size_t)b * PAST * NH + head) * DH; const float* vb = F.cv + ((size_t)b * PAST * NH + head) * DH;
    const int lrow = lane >> 5, lch = lane & 31;
    for (int jt = PAST / 32 - 1 - w; jt >= 0; jt -= NWAVES) {
        cache_tile_to_image(kb + (size_t)(32 * jt) * (NH * DH), kimg, lrow, lch);
        if (flash_qk<true>(false, qf, qimg, kimg, 0, c2 + 32 * jt, cq2, 0, 0, m, l, o, pf0, pf1, lane, fa)) {
            cache_tile_to_image(vb + (size_t)(32 * jt) * (NH * DH), vimg, lrow, lch);
            flash_pv(vimg, 0, pf0, pf1, o, fa);
        }
    }
    LAS float* ms = (LAS float*)(F.lds + SCR_OFF);
    l += __shfl_xor(l, 32);
    if (h == 0) ms[w * 32 + c] = m;
    __syncthreads();
    float mg = ms[c];
#pragma unroll
    for (int j = 1; j < 8; ++j) mg = fmaxf(mg, ms[j * 32 + c]);
    const float a = fexp2(m - mg);
    if (h == 0) ms[256 + w * 32 + c] = l * a;
    LAS uchar* po = F.lds + RING_OFF + w * 16384;
#pragma unroll
    for (int dt = 0; dt < 4; ++dt)
#pragma unroll
        for (int g = 0; g < 4; ++g) { const unsigned chk = (unsigned)(8 * dt + 2 * g + h) ^ (unsigned)c;
            *(LAS f32x4*)(po + c * 512 + chk * 16) = (f32x4){o[dt][4 * g] * a, o[dt][4 * g + 1] * a, o[dt][4 * g + 2] * a, o[dt][4 * g + 3] * a}; }
    __syncthreads();
    float lt = 0.f;
#pragma unroll
    for (int j = 0; j < 8; ++j) lt += ms[256 + j * 32 + c];
    const float inv = 1.0f / lt;
    f32x4 s0 = {0.f, 0.f, 0.f, 0.f}, s1 = {0.f, 0.f, 0.f, 0.f};
#pragma unroll
    for (int j = 0; j < 8; ++j) { const LAS uchar* pj = F.lds + RING_OFF + j * 16384 + c * 512;
        s0 += *(const LAS f32x4*)(pj + (((unsigned)(4 * w + 2 * h) ^ (unsigned)c) * 16)); s1 += *(const LAS f32x4*)(pj + (((unsigned)(4 * w + 2 * h + 1) ^ (unsigned)c) * 16)); }
    s0 = s0 * inv; s1 = s1 * inv;
    u32x4 ow; ow[0] = pk2(s0[0], s0[1]); ow[1] = pk2(s0[2], s0[3]); ow[2] = pk2(s1[0], s1[1]); ow[3] = pk2(s1[2], s1[3]);
    *(u32x4*)(wsp<bf16>(F, WS_OB) + (size_t)rowq * W1K + head * DH + 16 * w + 8 * h) = ow;
    __syncthreads();
}
DI void p6_attn_sample(const Frame& F) { for (int su = F.bid; su < NB_S * NH; su += F.G) attn_sample_unit(F, su); }

DI void p_norm2(const Frame& F) {
    const int gw = F.bid * NWAVES + F.wave, NGW = F.G * NWAVES;
    for (int m = gw; m < MROWS; m += NGW) rms_row_bf16<false>(F, wsp<float>(F, WS_X1) + (size_t)m * D_MODEL, F.norm2, wsp<bf16>(F, WS_H) + (size_t)m * D_MODEL, m);
}
DI void p_norm_final(const Frame& F) {
    const int gw = F.bid * NWAVES + F.wave, NGW = F.G * NWAVES;
    for (int m = gw; m < MROWS; m += NGW) {
        f32x4* xv = (f32x4*)(F.out + OUT_Y + (size_t)m * D_MODEL) + F.lane; const f32x4* gv = (const f32x4*)F.norm_f + F.lane;
        f32x4 v[8]; float s = 0.f;
#pragma unroll
        for (int j = 0; j < 8; ++j) { v[j] = xv[64 * j]; s += (v[j][0] * v[j][0] + v[j][1] * v[j][1]) + (v[j][2] * v[j][2] + v[j][3] * v[j][3]); }
        const float rstd = 1.0f / sqrtf(wave_sum(s) * (1.0f / D_MODEL) + EPS);
#pragma unroll
        for (int j = 0; j < 8; ++j) xv[64 * j] = v[j] * rstd * gv[64 * j];
    }
}

constexpr int N_PHASES = 14;
struct Args { const float* in[18]; float* out; uchar* ws; int ph_lo, ph_hi; };
__global__ void __launch_bounds__(NWAVES * 64, 2) fwd_kernel(Args args) {
    extern __shared__ __attribute__((aligned(16))) uchar lds_raw[];
    Frame F;
    F.lds = (LAS uchar*)lds_raw;
    F.tid = threadIdx.x; F.lane = F.tid & 63; F.wave = __builtin_amdgcn_readfirstlane(F.tid >> 6);
    F.G = gridDim.x; F.bid = blockIdx.x;
    F.x_p = args.in[0]; F.x_s = args.in[1]; F.ck = args.in[2]; F.cv = args.in[3]; F.clf = args.in[4]; F.st0 = args.in[5]; F.norm1 = args.in[6]; F.w_in = args.in[7]; F.b_fox = args.in[8];
    F.lb_logits = args.in[9]; F.gnorm = args.in[10]; F.w_pa = args.in[11]; F.w_pb = args.in[12]; F.w_o = args.in[13]; F.norm2 = args.in[14]; F.w1 = args.in[15]; F.w2 = args.in[16]; F.norm_f = args.in[17];
    F.out = args.out; F.ws = args.ws;
    for (int u = F.tid; u < (LDS_BYTES - LDSCTL_OFF) / 4; u += NWAVES * 64) ((LAS unsigned*)(F.lds + LDSCTL_OFF))[u] = 0u;
    __syncthreads();
    const int lo = args.ph_lo, hi = args.ph_hi;
    const bool multi = (hi - lo) > 1;
    XcdBarrier bar; bar.bar = (unsigned*)(F.ws + WS_CTL) + CW_BAR; bar.x = 0; bar.st = nullptr;
    if (multi) bar = xcd_barrier_post((unsigned*)(F.ws + WS_CTL) + CW_BAR, (volatile LAS unsigned*)(F.lds + MISC_OFF) + 8);
#ifndef PH_MASK
#define PH_MASK 0xffffffffu
#endif
#define IN(k) (((PH_MASK >> (k)) & 1u) && lo <= (k) && (k) < hi)
#define SEAM(k) do { if (IN(k) && IN((k) + 1)) xcd_barrier(bar); } while (0)
    LAS uchar* ring = F.lds + RING_OFF;

    if (IN(0)) { p0_prologue(F); } SEAM(0);
    if (IN(1)) {
        pg8::Gemm g{wsp<bf16>(F, WS_H), wsp<bf16>(F, WS_WIN), MROWS, N_INP, D_MODEL}; pg8::StaticOrder S; S.init(MROWS, N_INP, F.G, F.bid);
        pg8::EpiInProj E{F.ws, F.out};
        pg8::gemm_phase<pg8::EpiInProj, pg8::StaticOrder, true, true>(ring, g, S, E);
    } SEAM(1);
    if (IN(2)) { p2_scans(F); p3_hgrn_local(F); } SEAM(2);
    if (IN(3)) { p4_hgrn_scan(F); } SEAM(3);
    if (IN(4)) { p5_hgrn_out(F); } SEAM(4);
    if (IN(5)) { p6_attn_prompt(F); } SEAM(5);
    if (IN(6)) { p6_attn_sample(F); } SEAM(6);
    if (IN(7)) {
        pg8::Gemm g{wsp<bf16>(F, WS_OA), wsp<bf16>(F, WS_WPA), MROWS, D_MODEL, W1K}; pg8::StaticOrder S; S.init(MROWS, D_MODEL, F.G, F.bid);
        pg8::EpiMix<0> E{wsp<bf16>(F, WS_G), wsp<float>(F, WS_T1), nullptr, 0};
        pg8::gemm_phase<pg8::EpiMix<0>, pg8::StaticOrder, true, true>(ring, g, S, E);
    } SEAM(7);
    if (IN(8)) {
        pg8::Gemm g{wsp<bf16>(F, WS_OB), wsp<bf16>(F, WS_WPB), MROWS, D_MODEL, W1K}; pg8::StaticOrder S; S.init(MROWS, D_MODEL, F.G, F.bid);
        pg8::EpiMix<1> E{wsp<bf16>(F, WS_G), wsp<float>(F, WS_T1), wsp<bf16>(F, WS_MG), 0};
        pg8::gemm_phase<pg8::EpiMix<1>, pg8::StaticOrder, true, true>(ring, g, S, E);
    } SEAM(8);
    if (IN(9)) {
        pg8::Gemm g{wsp<bf16>(F, WS_MG), wsp<bf16>(F, WS_WO), MROWS, D_MODEL, D_MODEL}; pg8::StaticOrder S; S.init(MROWS, D_MODEL, F.G, F.bid);
        pg8::EpiResid E{F.x_p, F.x_s - (size_t)MP * D_MODEL, wsp<float>(F, WS_X1)};
        pg8::gemm_phase<pg8::EpiResid, pg8::StaticOrder, true, true>(ring, g, S, E);
    } SEAM(9);
    if (IN(10)) { p_norm2(F); } SEAM(10);
    if (IN(11)) {
        pg8::Gemm g{wsp<bf16>(F, WS_H), wsp<bf16>(F, WS_W1), MROWS, D_FF, D_MODEL}; pg8::StaticOrder S; S.init(MROWS, D_FF, F.G, F.bid);
        pg8::EpiMix<2> E{nullptr, nullptr, wsp<bf16>(F, WS_U), D_FF};
        pg8::gemm_phase<pg8::EpiMix<2>, pg8::StaticOrder, true, true>(ring, g, S, E);
    } SEAM(11);
    if (IN(12)) {
        pg8::Gemm g{wsp<bf16>(F, WS_U), wsp<bf16>(F, WS_W2), MROWS, D_MODEL, D_FF}; pg8::StaticOrder S; S.init(MROWS, D_MODEL, F.G, F.bid);
        pg8::EpiResid E{wsp<float>(F, WS_X1), wsp<float>(F, WS_X1), F.out + OUT_Y};
        pg8::gemm_phase<pg8::EpiResid, pg8::StaticOrder, true, true>(ring, g, S, E);
    } SEAM(12);
    if (IN(13)) { p_norm_final(F); }
#undef IN
#undef SEAM
}

#ifndef MK_ONE_LAUNCH
#define MK_ONE_LAUNCH 1
#endif
extern "C" void kernel_launch(void* const* d_in, const int* in_sizes, int n_in, void* d_out, int out_size, void* d_ws, size_t ws_size, hipStream_t stream) {
    static int grid = 0;
    if (grid == 0) {
        if (n_in != 18 || (size_t)out_size != OUT_END || ws_size < WS_END) { fprintf(stderr, "kernel_launch: unexpected sizes: n_in %d out %d ws %zu (need out %zu ws %zu)\n", n_in, out_size, ws_size, (size_t)OUT_END, (size_t)WS_END); grid = -1; return; }
        int dev = 0, cus = 0, per_cu = 0;
        if (hipGetDevice(&dev) != hipSuccess || hipDeviceGetAttribute(&cus, hipDeviceAttributeMultiprocessorCount, dev) != hipSuccess) { grid = -1; return; }
        if (hipFuncSetAttribute((const void*)fwd_kernel, hipFuncAttributeMaxDynamicSharedMemorySize, LDS_BYTES) != hipSuccess) { fprintf(stderr, "kernel_launch: hipFuncSetAttribute failed\n"); grid = -1; return; }
        if (hipOccupancyMaxActiveBlocksPerMultiprocessor(&per_cu, (const void*)fwd_kernel, NWAVES * 64, LDS_BYTES) != hipSuccess || per_cu < 1)
            fprintf(stderr, "kernel_launch: note: occupancy query reports %d workgroups per CU\n", per_cu);
        (void)hipGetLastError();
        grid = cus;
    }
    if (grid < 0) return;
    if (hipMemsetAsync((char*)d_ws + WS_CTL, 0, CTL_ZERO_BYTES, stream) != hipSuccess) { fprintf(stderr, "kernel_launch: memset failed\n"); return; }
    Args a{};
    for (int i = 0; i < 18; ++i) a.in[i] = (const float*)d_in[i];
    a.out = (float*)d_out; a.ws = (uchar*)d_ws;
#if MK_ONE_LAUNCH
    a.ph_lo = 0; a.ph_hi = N_PHASES;
    hipLaunchKernelGGL(fwd_kernel, dim3(grid), dim3(NWAVES * 64), LDS_BYTES, stream, a);
#else
    for (int p = 0; p < N_PHASES; ++p) { a.ph_lo = p; a.ph_hi = p + 1; hipLaunchKernelGGL(fwd_kernel, dim3(grid), dim3(NWAVES * 64), LDS_BYTES, stream, a); }
#endif
    const hipError_t le = hipPeekAtLastError();
    if (le != hipSuccess) fprintf(stderr, "kernel_launch: launch failed: %s\n", hipGetErrorName(le));
}
```

```cpp
#include <hip/hip_runtime.h>
#include <cstdio>
#include <cstdint>

constexpr int D_MODEL = 2048, SEQ = 4096, NB_P = 2, NB_S = 32, T_S = 32, PAST = 4096;
constexpr int MP = NB_P * SEQ;
constexpr int MS = NB_S * T_S;
constexpr int MROWS = MP + MS;
constexpr int NH = 8, DH = 128, W1K = 1024;
constexpr int D_FF = 8192;
constexpr int N_IN = 11272;
constexpr int N_INP = 11264;
constexpr int COL_FL = 7168;
constexpr int CHK = 32;
constexpr int NCH = SEQ / CHK;
constexpr int NU_P = NB_P * NH * NCH;
constexpr int NU_S = NB_S * NH;
constexpr int NU = NU_P + NU_S;
constexpr int SKV_S = PAST + T_S;
constexpr float EPS = 1e-6f;
constexpr float LOG2E = 1.4426950408889634f;
constexpr float QSCALE = 0.08838834764831845f * LOG2E;

#define GAS __attribute__((address_space(1)))
#define LAS __attribute__((address_space(3)))
#define DI __device__ __forceinline__
typedef unsigned short bf16;
typedef unsigned char uchar;
typedef short bf16x8 __attribute__((ext_vector_type(8)));
typedef short s16x4 __attribute__((ext_vector_type(4)));
typedef float f32x2 __attribute__((ext_vector_type(2)));
typedef float f32x4 __attribute__((ext_vector_type(4)));
typedef float f32x16 __attribute__((ext_vector_type(16)));
typedef unsigned u32x2 __attribute__((ext_vector_type(2)));
typedef unsigned u32x4 __attribute__((ext_vector_type(4)));
typedef __bf16 nbf2 __attribute__((ext_vector_type(2)));

DI unsigned pk2(float lo, float hi) { f32x2 x = {lo, hi}; nbf2 y = __builtin_convertvector(x, nbf2); return __builtin_bit_cast(unsigned, y); }
DI float bf_lo(unsigned u) { return __uint_as_float(u << 16); }
DI float bf_hi(unsigned u) { return __uint_as_float(u & 0xffff0000u); }
DI float fexp2(float x) { return __builtin_amdgcn_exp2f(x); }
DI float fexp(float x) { return __builtin_amdgcn_exp2f(x * LOG2E); }
DI float frcp(float x) { return __builtin_amdgcn_rcpf(x); }
DI float flog(float x) { return __builtin_amdgcn_logf(x) * 0.6931471805599453f; }
DI float fsigmoid(float x) { return frcp(1.0f + fexp(-x)); }
DI float fsilu(float x) { return x * fsigmoid(x); }
DI float wave_sum(float v) {
#pragma unroll
    for (int o = 1; o < 64; o <<= 1) v += __shfl_xor(v, o);
    return v;
}
#define MFMA32(a, b, c) __builtin_amdgcn_mfma_f32_32x32x16_bf16((a), (b), (c), 0, 0, 0)

DI unsigned off_a(unsigned row, unsigned ch) { return 2048u * (row >> 3) + 512u * (ch >> 2) + 64u * (row & 7u) + 16u * ((ch & 3u) ^ ((row >> 2) & 3u)); }
struct FragAddr { unsigned row_e, row_o, trn0, trn1, trp0, trp1; };
DI FragAddr make_frag_addr(int lane) {
    FragAddr a; const unsigned r = lane & 31, h = lane >> 5, blk = (lane >> 4) & 1, q = (lane & 15) >> 2, p = lane & 3;
    a.row_e = off_a(r, h); a.row_o = off_a(r, 2 + h);
    const unsigned ch = 2 * blk + (p >> 1);
    a.trn0 = off_a(8 * h + q, ch) + 8 * (p & 1); a.trn1 = off_a(8 * h + q + 4, ch) + 8 * (p & 1);
    a.trp0 = off_a(4 * h + q, ch) + 8 * (p & 1); a.trp1 = off_a(4 * h + q + 8, ch) + 8 * (p & 1);
    return a;
}
DI bf16x8 frag_row(LAS uchar* img, const FragAddr& fa, int R0, int s) { return *(LAS bf16x8*)(img + ((s & 1) ? fa.row_o : fa.row_e) + 256 * R0 + 512 * (s >> 1)); }
template <bool PERM> DI bf16x8 frag_tr(LAS uchar* img, const FragAddr& fa, int K0, int c, int ks) {
    const int imm = 256 * K0 + 4096 * ks + 512 * c;
    const s16x4 lo = __builtin_amdgcn_ds_read_tr16_b64_v4i16((LAS s16x4*)(img + (PERM ? fa.trp0 : fa.trn0) + imm));
    const s16x4 hi = __builtin_amdgcn_ds_read_tr16_b64_v4i16((LAS s16x4*)(img + (PERM ? fa.trp1 : fa.trn1) + imm));
    return (bf16x8){lo[0], lo[1], lo[2], lo[3], hi[0], hi[1], hi[2], hi[3]};
}
DI bf16x8 pack_acc(const f32x16& x, int s) {
    u32x4 p;
    p[0] = pk2(x[8 * s + 0], x[8 * s + 1]); p[1] = pk2(x[8 * s + 2], x[8 * s + 3]); p[2] = pk2(x[8 * s + 4], x[8 * s + 5]); p[3] = pk2(x[8 * s + 6], x[8 * s + 7]);
    return __builtin_bit_cast(bf16x8, p);
}

constexpr size_t MiB = 1u << 20;
constexpr size_t WS_CTL = 0, CTL_ZERO_BYTES = 1 * MiB;
constexpr size_t WS_WIN = 2 * MiB;
constexpr size_t WS_WPA = 46 * MiB, WS_WPB = 50 * MiB;
constexpr size_t WS_WO = 54 * MiB;
constexpr size_t WS_W1 = 62 * MiB;
constexpr size_t WS_W2 = 94 * MiB;
constexpr size_t WS_H = 126 * MiB;
constexpr size_t WS_QA = 162 * MiB, WS_VA = 180 * MiB, WS_GA = 198 * MiB, WS_QB = 216 * MiB, WS_KB = 234 * MiB, WS_VB = 252 * MiB;
constexpr size_t WS_LFA = 270 * MiB;
constexpr size_t WS_G = 306 * MiB;
constexpr size_t WS_LFB = 378 * MiB;
constexpr size_t WS_LB = 379 * MiB;
constexpr size_t WS_C2P = 380 * MiB;
constexpr size_t WS_C2S = 381 * MiB;
constexpr size_t WS_DEC = 386 * MiB;
constexpr size_t WS_DS = 388 * MiB;
constexpr size_t WS_SP = 532 * MiB;
constexpr size_t WS_OA = 596 * MiB, WS_OB = 614 * MiB;
constexpr size_t WS_T1 = 632 * MiB;
constexpr size_t WS_MG = 704 * MiB;
constexpr size_t WS_X1 = 740 * MiB;
constexpr size_t WS_U = 812 * MiB;
constexpr size_t WS_END = 956 * MiB;
constexpr int CW_BAR = 4096;
constexpr size_t OUT_Y = 0, OUT_KP = (size_t)MROWS * 2048, OUT_VP = OUT_KP + (size_t)MP * 1024, OUT_LFP = OUT_VP + (size_t)MP * 1024, OUT_SP = OUT_LFP + (size_t)MP * 8,
                 OUT_KS = OUT_SP + (size_t)NB_P * NH * 128 * 128, OUT_VS = OUT_KS + (size_t)MS * 1024, OUT_LFS = OUT_VS + (size_t)MS * 1024, OUT_SS = OUT_LFS + (size_t)MS * 8,
                 OUT_END = OUT_SS + (size_t)NB_S * NH * 128 * 128;
constexpr int NWAVES = 8;
constexpr int RING_OFF = 0, RING_BYTES = 131072;
constexpr int LDSCTL_OFF = RING_BYTES, MISC_OFF = LDSCTL_OFF + 320;
constexpr int SCR_OFF = RING_BYTES + 1024;
constexpr int QIMG_OFF = SCR_OFF + 8192;
constexpr int LDS_BYTES = 163840;

#define RLX_AGENT __ATOMIC_RELAXED, __HIP_MEMORY_SCOPE_AGENT
namespace pg8 {
#define PG8_LAS __attribute__((address_space(3)))
typedef unsigned short bf16_t;
typedef short bf16x8 __attribute__((ext_vector_type(8)));
typedef float f32x4 __attribute__((ext_vector_type(4)));
typedef unsigned u32x4 __attribute__((ext_vector_type(4)));
constexpr int BM = 256, BK = 64, HALF = 128, HTB = HALF * BK * 2  , STAGE_BYTES = 8 * HTB, NXCD = 8, WGM = 8;

__host__ __device__ __forceinline__ int lds_byte(int r, int c) { const int st = (r >> 4) * 2 + (c >> 5), rr = r & 15, cc = c & 31, ob = rr * 64 + cc * 2; return st * 1024 + (ob ^ (((ob >> 9) & 1) << 5)); }
__host__ __device__ __forceinline__ void stage_rc(int b, int& R, int& C) { const int st = b / 1024, sb = b % 1024, swz = sb ^ (((sb >> 9) & 1) << 5); R = (st >> 1) * 16 + swz / 64; C = (st & 1) * 32 + (swz % 64) / 2; }
__host__ __device__ __forceinline__ int perm32(int rho) { const int n = rho >> 4, i = rho & 15; return 8 * (i >> 2) + 4 * n + (i & 3); }

struct Unit { int pm, pn, k0, nt, ks; };
struct Gemm { const bf16_t* A; const bf16_t* Bt; int M, N, K; };

struct StaticOrder {
    int nM, nN, nwg, G, c;
    __host__ __device__ __forceinline__ void init(int M, int N, int G_, int c_) { nM = M / BM; nN = N / BM; nwg = nM * nN; G = G_; c = c_; }
    __host__ __device__ __forceinline__ void map(int wgid, int& pm, int& pn) const {
        { const int q = nwg / NXCD, r = nwg % NXCD, xcd = wgid % NXCD, off = wgid / NXCD; wgid = (xcd < r ? xcd * (q + 1) : r * (q + 1) + (xcd - r) * q) + off; }
        const int nig = WGM * nN, gid = wgid / nig, fm = gid * WGM, gsz = (nM - fm) < WGM ? (nM - fm) : WGM;
        pm = fm + ((wgid % nig) % gsz); pn = (wgid % nig) / gsz;
    }
    __host__ __device__ __forceinline__ bool next(int i, Unit& u) const {
        const long L = (long)i * G + c; if (L >= nwg) return false;
        int pm, pn; map((int)L, pm, pn);
        u = Unit{pm, pn, 0, 0, -1}; return true;
    }
    __device__ __forceinline__ void a_ready(const Unit&) const {}
    __device__ __forceinline__ void done(const Unit&) const {}
};


template <class Epi, class Sched, bool ALIGN_EPI = false, bool SP2 = false>
__device__ __forceinline__ void gemm_phase(PG8_LAS unsigned char* lds, const Gemm g, const Sched& S, const Epi& E) {
    const int tid = threadIdx.x, wid = __builtin_amdgcn_readfirstlane(tid >> 6), lane = tid & 63, wr = wid >> 2, wc = wid & 3, fr = lane & 15, fq = lane >> 4;
    const int K = g.K;
    unsigned voffA[2], voffB[2];
#pragma unroll
    for (int i = 0; i < 2; ++i) { int R, C; stage_rc(tid * 16 + i * 8192, R, C); const int Rb = Epi::PERM ? ((R & ~31) + perm32(R & 31)) : R;
        voffA[i] = (unsigned)(R * K + C) * 2u; voffB[i] = (unsigned)(Rb * K + C) * 2u; }
    const size_t kstep = (size_t)(BK * 2);
    const size_t hstep = (size_t)HALF * K * 2;
    const size_t tstep = 2 * hstep;
    const unsigned ldsw = (unsigned)wid * 1024u;
    const int aoff = lds_byte(wr * 64 + fr, fq * 8), boff = lds_byte(wc * 32 + fr, fq * 8);
#define PG8_SA(b, h) (((b) * 2 + (h)) * HTB)
#define PG8_SB(b, h) ((4 + (b) * 2 + (h)) * HTB)
#define PG8_STAGE(bufoff, gbase, voff) do { _Pragma("unroll") for (int _i = 0; _i < 2; ++_i) \
        __builtin_amdgcn_global_load_lds((const unsigned*)((const char*)(gbase) + (voff)[_i]), (PG8_LAS unsigned*)(lds + (bufoff) + ldsw + _i * 8192), 16, 0, 0); } while (0)
#define PG8_LDA(dst, b, h) do { _Pragma("unroll") for (int m = 0; m < 4; ++m) _Pragma("unroll") for (int k = 0; k < 2; ++k) dst[m][k] = *(const PG8_LAS bf16x8*)(lds + PG8_SA(b, h) + aoff + m * 2048 + k * 1024); } while (0)
#define PG8_LDB(dst, b, h) do { _Pragma("unroll") for (int n = 0; n < 2; ++n) _Pragma("unroll") for (int k = 0; k < 2; ++k) dst[n][k] = *(const PG8_LAS bf16x8*)(lds + PG8_SB(b, h) + boff + n * 2048 + k * 1024); } while (0)
#define PG8_MMA(ai, bj, At, Bt) do { __builtin_amdgcn_s_setprio(1); _Pragma("unroll") for (int m = 0; m < 4; ++m) _Pragma("unroll") for (int n = 0; n < 2; ++n) _Pragma("unroll") for (int k = 0; k < 2; ++k) \
        acc[ai][bj][m][n] = __builtin_amdgcn_mfma_f32_16x16x32_bf16(Bt[n][k], At[m][k], acc[ai][bj][m][n], 0, 0, 0); __builtin_amdgcn_s_setprio(0); } while (0)
#define PG8_WAIT_V(n) asm volatile("s_waitcnt vmcnt(" #n ")" ::: "memory")
#define PG8_WAIT_L(n) asm volatile("s_waitcnt lgkmcnt(" #n ")" ::: "memory")
#define PG8_BAR __builtin_amdgcn_s_barrier()
#define PG8_SCHED __builtin_amdgcn_sched_barrier(0)
    Unit cur, nxt; int ui = 0;
    if (!S.next(0, cur)) return;
    f32x4 acc[2][2][4][2];
#pragma unroll
    for (int a = 0; a < 2; ++a)
#pragma unroll
        for (int b = 0; b < 2; ++b)
#pragma unroll
            for (int m = 0; m < 4; ++m)
#pragma unroll
                for (int n = 0; n < 2; ++n) acc[a][b][m][n] = (f32x4){0.f, 0.f, 0.f, 0.f};
    bf16x8 At[4][2], B0[2][2], B1[2][2];
    const char* cA = (const char*)g.A + (size_t)cur.pm * tstep + (size_t)cur.k0 * kstep; const char* cB = (const char*)g.Bt + (size_t)cur.pn * tstep + (size_t)cur.k0 * kstep;
    S.a_ready(cur);
    if constexpr (SP2) {
        PG8_STAGE(PG8_SB(0, 0), cB, voffB); PG8_STAGE(PG8_SB(0, 1), cB + hstep, voffB); PG8_STAGE(PG8_SA(0, 0), cA, voffA); PG8_STAGE(PG8_SA(0, 1), cA + hstep, voffA);
        if (wr == 1) PG8_BAR;
        PG8_WAIT_V(2); PG8_BAR;
        PG8_STAGE(PG8_SB(1, 0), cB + kstep, voffB); PG8_STAGE(PG8_SA(1, 0), cA + kstep, voffA); PG8_STAGE(PG8_SB(1, 1), cB + hstep + kstep, voffB);
        PG8_WAIT_V(6); PG8_BAR;
    } else {
        PG8_STAGE(PG8_SB(0, 0), cB, voffB); PG8_STAGE(PG8_SA(0, 0), cA, voffA); PG8_STAGE(PG8_SB(0, 1), cB + hstep, voffB); PG8_STAGE(PG8_SA(0, 1), cA + hstep, voffA);
        if (wr == 1) PG8_BAR;
        PG8_WAIT_V(4); PG8_BAR;
        PG8_STAGE(PG8_SB(1, 0), cB + kstep, voffB); PG8_STAGE(PG8_SA(1, 0), cA + kstep, voffA); PG8_STAGE(PG8_SB(1, 1), cB + hstep + kstep, voffB);
        PG8_WAIT_V(6); PG8_BAR;
    }
    for (;;) {
        const bool has_next = S.next(ui + 1, nxt);
        const char* nA = has_next ? (const char*)g.A + (size_t)nxt.pm * tstep + (size_t)nxt.k0 * kstep : cA; const char* nB = has_next ? (const char*)g.Bt + (size_t)nxt.pn * tstep + (size_t)nxt.k0 * kstep : cB;
        const int nt = cur.nt ? cur.nt : K / BK;
        for (int t = 0; t < nt; t += 2) {
            if constexpr (Epi::MID) { if (t == E.tmid(cur)) E.mid(acc, cur, wr, wc, fr, fq); }
            const bool last = (t == nt - 2);
            const char* a1 = cA + (size_t)(t + 1) * kstep;
            const char* a2 = last ? nA : cA + (size_t)(t + 2) * kstep; const char* b2 = last ? nB : cB + (size_t)(t + 2) * kstep;
            const char* a3 = a2 + kstep; const char* b3 = b2 + kstep;
            if (last && has_next) S.a_ready(nxt);
            if constexpr (SP2) {
            PG8_LDB(B0, 0, 0); PG8_LDB(B1, 0, 1); PG8_SCHED; PG8_LDA(At, 0, 0); PG8_STAGE(PG8_SA(1, 1), a1 + hstep, voffA);
            PG8_WAIT_V(8); PG8_WAIT_L(0); PG8_BAR; PG8_MMA(0, 0, At, B0); PG8_MMA(0, 1, At, B1); PG8_BAR; PG8_SCHED;
            PG8_LDA(At, 0, 1); PG8_STAGE(PG8_SB(0, 0), b2, voffB); PG8_STAGE(PG8_SB(0, 1), b2 + hstep, voffB); PG8_STAGE(PG8_SA(0, 0), a2, voffA);
            PG8_WAIT_V(8); PG8_WAIT_L(0); PG8_BAR; PG8_MMA(1, 0, At, B0); PG8_MMA(1, 1, At, B1); PG8_BAR; PG8_SCHED;
            PG8_LDB(B0, 1, 0); PG8_LDB(B1, 1, 1); PG8_SCHED; PG8_LDA(At, 1, 0); PG8_STAGE(PG8_SA(0, 1), a2 + hstep, voffA);
            PG8_WAIT_V(8); PG8_WAIT_L(0); PG8_BAR; PG8_MMA(0, 0, At, B0); PG8_MMA(0, 1, At, B1); PG8_BAR; PG8_SCHED;
            PG8_LDA(At, 1, 1); PG8_STAGE(PG8_SB(1, 0), b3, voffB); PG8_STAGE(PG8_SB(1, 1), b3 + hstep, voffB); PG8_STAGE(PG8_SA(1, 0), a3, voffA);
            PG8_WAIT_V(8); PG8_WAIT_L(0); PG8_BAR; PG8_MMA(1, 0, At, B0); PG8_MMA(1, 1, At, B1); PG8_BAR; PG8_SCHED;
            } else {
            PG8_LDB(B0, 0, 0); PG8_SCHED; PG8_LDA(At, 0, 0); PG8_STAGE(PG8_SA(1, 1), a1 + hstep, voffA);
            PG8_WAIT_L(8); PG8_BAR; PG8_WAIT_L(0); PG8_MMA(0, 0, At, B0); PG8_BAR; PG8_SCHED;
            PG8_LDB(B1, 0, 1); PG8_STAGE(PG8_SB(0, 0), b2, voffB);
            PG8_BAR; PG8_WAIT_L(0); PG8_MMA(0, 1, At, B1); PG8_BAR;
            PG8_LDA(At, 0, 1); PG8_STAGE(PG8_SA(0, 0), a2, voffA);
            PG8_BAR; PG8_WAIT_L(0); PG8_MMA(1, 0, At, B0); PG8_BAR; PG8_SCHED;
            PG8_STAGE(PG8_SB(0, 1), b2 + hstep, voffB);
            PG8_WAIT_V(6); PG8_BAR; PG8_MMA(1, 1, At, B1); PG8_BAR;
            PG8_LDB(B0, 1, 0); PG8_SCHED; PG8_LDA(At, 1, 0); PG8_STAGE(PG8_SA(0, 1), a2 + hstep, voffA);
            PG8_WAIT_L(8); PG8_BAR; PG8_WAIT_L(0); PG8_MMA(0, 0, At, B0); PG8_BAR; PG8_SCHED;
            PG8_LDB(B1, 1, 1); PG8_STAGE(PG8_SB(1, 0), b3, voffB);
            PG8_BAR; PG8_WAIT_L(0); PG8_MMA(0, 1, At, B1); PG8_BAR;
            PG8_LDA(At, 1, 1); PG8_STAGE(PG8_SA(1, 0), a3, voffA);
            PG8_BAR; PG8_WAIT_L(0); PG8_MMA(1, 0, At, B0); PG8_BAR; PG8_SCHED;
            PG8_STAGE(PG8_SB(1, 1), b3 + hstep, voffB);
            PG8_WAIT_V(6); PG8_BAR; PG8_MMA(1, 1, At, B1); PG8_BAR;
            }
        }
        if constexpr (ALIGN_EPI) { if (wr == 0) PG8_BAR; }
        if constexpr (!Epi::AFTER_DRAIN) { E(acc, cur, wr, wc, fr, fq); S.done(cur); }
        if (!has_next) break;
#pragma unroll
        for (int a = 0; a < 2; ++a)
#pragma unroll
            for (int b = 0; b < 2; ++b)
#pragma unroll
                for (int m = 0; m < 4; ++m)
#pragma unroll
                    for (int n = 0; n < 2; ++n) acc[a][b][m][n] = (f32x4){0.f, 0.f, 0.f, 0.f};
        cur = nxt; cA = nA; cB = nB; ++ui;
        if constexpr (ALIGN_EPI) { if (wr == 1) PG8_BAR; }
    }
    PG8_WAIT_V(0);
    if constexpr (!ALIGN_EPI) { if (wr == 0) PG8_BAR; }
    PG8_BAR;
    if constexpr (Epi::AFTER_DRAIN) { E.fused(acc, cur, wr, wc, fr, fq, lds, wid, lane); S.done(cur); }
#undef PG8_SA
#undef PG8_SB
#undef PG8_STAGE
#undef PG8_LDA
#undef PG8_LDB
#undef PG8_MMA
#undef PG8_WAIT_V
#undef PG8_WAIT_L
#undef PG8_BAR
#undef PG8_SCHED
}
}

namespace pg8 {
DI void unpack8(const u32x4 w, float (&f)[8]) { f[0] = bf_lo(w[0]); f[1] = bf_hi(w[0]); f[2] = bf_lo(w[1]); f[3] = bf_hi(w[1]); f[4] = bf_lo(w[2]); f[5] = bf_hi(w[2]); f[6] = bf_lo(w[3]); f[7] = bf_hi(w[3]); }

struct EpiInProj {
    static constexpr bool PERM = true, AFTER_DRAIN = false, MID = false;
    uchar* ws; float* out;
    DI void operator()(const f32x4 (&acc)[2][2][4][2], const Unit& u0, int wr, int wc, int fr, int fq) const {
        Unit u = u0; asm volatile("" : "+s"(u.pm), "+s"(u.pn));
        { int ln; asm volatile("v_mbcnt_lo_u32_b32 %0, -1, 0\n\tv_mbcnt_hi_u32_b32 %0, -1, %0" : "=v"(ln)); fr = ln & 15; fq = ln >> 4; }
        const int grp = u.pn < 28 ? (u.pn >> 2) : 7;
        const int ld = (grp == 7) ? 4096 : 1024;
        const int cg0 = ((grp == 7) ? (u.pn - 28) : (u.pn & 3)) * BM + wc * 32 + 8 * fq;
        const size_t oboff = grp == 0 ? WS_QA : grp == 1 ? WS_LFA : grp == 2 ? WS_VA : grp == 3 ? WS_GA : grp == 4 ? WS_QB : grp == 5 ? WS_KB : grp == 6 ? WS_VB : WS_G;
        uchar* ob = ws + oboff;
        float* of = out + ((grp == 5) ? ((u.pm < 32) ? OUT_KP : OUT_KS - (size_t)MP * 1024) : ((u.pm < 32) ? OUT_VP : OUT_VS - (size_t)MP * 1024));
        float lb[2][8];
#pragma unroll
        for (int bj = 0; bj < 2; ++bj)
#pragma unroll
            for (int e = 0; e < 8; ++e) lb[bj][e] = 0.f;
        if (grp == 1) { const float* LB = (const float*)(ws + WS_LB);
#pragma unroll
            for (int bj = 0; bj < 2; ++bj) { const f32x4 a = *(const f32x4*)(LB + cg0 + bj * HALF), b = *(const f32x4*)(LB + cg0 + bj * HALF + 4);
                lb[bj][0] = a[0]; lb[bj][1] = a[1]; lb[bj][2] = a[2]; lb[bj][3] = a[3]; lb[bj][4] = b[0]; lb[bj][5] = b[1]; lb[bj][6] = b[2]; lb[bj][7] = b[3]; }
        }
#pragma unroll
        for (int ai = 0; ai < 2; ++ai)
#pragma unroll
            for (int m = 0; m < 4; ++m) {
                const size_t roff = (size_t)(u.pm * BM + wr * 64 + fr + ai * HALF + m * 16) * ld + cg0;
#pragma unroll
                for (int bj = 0; bj < 2; ++bj) {
                    float v[8];
#pragma unroll
                    for (int e = 0; e < 4; ++e) { v[e] = acc[ai][bj][m][0][e]; v[4 + e] = acc[ai][bj][m][1][e]; }
                    if (grp == 5 || grp == 6) { *(f32x4*)(of + roff + bj * HALF) = acc[ai][bj][m][0]; *(f32x4*)(of + roff + bj * HALF + 4) = acc[ai][bj][m][1]; }
                    if (grp == 0 || grp == 3) {
#pragma unroll
                        for (int e = 0; e < 8; ++e) v[e] = fsilu(v[e]);
                    } else if (grp == 1) {
#pragma unroll
                        for (int e = 0; e < 8; ++e) { const float s = fsigmoid(v[e]); v[e] = flog(lb[bj][e] + (1.0f - lb[bj][e]) * s); }
                    } else if (grp == 4) {
#pragma unroll
                        for (int e = 0; e < 8; ++e) v[e] *= QSCALE;
                    } else if (grp == 7) {
#pragma unroll
                        for (int e = 0; e < 8; ++e) v[e] = fsigmoid(v[e]);
                    }
                    if (grp == 1) { float* p = (float*)ob + roff + bj * HALF; *(f32x4*)p = (f32x4){v[0], v[1], v[2], v[3]}; *(f32x4*)(p + 4) = (f32x4){v[4], v[5], v[6], v[7]}; }
                    else { u32x4 w; w[0] = pk2(v[0], v[1]); w[1] = pk2(v[2], v[3]); w[2] = pk2(v[4], v[5]); w[3] = pk2(v[6], v[7]); *(u32x4*)((bf16*)ob + roff + bj * HALF) = w; }
                }
            }
    }
};

template <int MODE> struct EpiMix {
    static constexpr bool PERM = true, AFTER_DRAIN = false, MID = false;
    const bf16* G; float* T1; bf16* O; int ld;
    DI void operator()(const f32x4 (&acc)[2][2][4][2], const Unit& u, int wr, int wc, int fr, int fq) const {
        const int row0 = u.pm * BM + wr * 64 + fr, col0 = u.pn * BM + wc * 32 + 8 * fq;
#pragma unroll
        for (int ai = 0; ai < 2; ++ai)
#pragma unroll
            for (int m = 0; m < 4; ++m) {
                const int r = row0 + ai * HALF + m * 16;
#pragma unroll
                for (int bj = 0; bj < 2; ++bj) {
                    const int c = col0 + bj * HALF;
                    float v[8];
#pragma unroll
                    for (int e = 0; e < 4; ++e) { v[e] = acc[ai][bj][m][0][e]; v[4 + e] = acc[ai][bj][m][1][e]; }
                    if (MODE == 0) {
                        float g[8]; unpack8(*(const u32x4*)(G + (size_t)r * 4096 + c), g);
                        float* t = T1 + (size_t)r * 2048 + c;
                        *(f32x4*)t = (f32x4){v[0] * g[0], v[1] * g[1], v[2] * g[2], v[3] * g[3]}; *(f32x4*)(t + 4) = (f32x4){v[4] * g[4], v[5] * g[5], v[6] * g[6], v[7] * g[7]};
                    } else if (MODE == 1) {
                        float g[8]; unpack8(*(const u32x4*)(G + (size_t)r * 4096 + 2048 + c), g);
                        const float* t = T1 + (size_t)r * 2048 + c; const f32x4 t0 = *(const f32x4*)t, t1 = *(const f32x4*)(t + 4);
                        u32x4 w; w[0] = pk2(t0[0] + v[0] * g[0], t0[1] + v[1] * g[1]); w[1] = pk2(t0[2] + v[2] * g[2], t0[3] + v[3] * g[3]);
                        w[2] = pk2(t1[0] + v[4] * g[4], t1[1] + v[5] * g[5]); w[3] = pk2(t1[2] + v[6] * g[6], t1[3] + v[7] * g[7]);
                        *(u32x4*)(O + (size_t)r * 2048 + c) = w;
                    } else {
#pragma unroll
                        for (int e = 0; e < 8; ++e) { const float t = fmaxf(v[e], 0.f); v[e] = t * t; }
                        u32x4 w; w[0] = pk2(v[0], v[1]); w[1] = pk2(v[2], v[3]); w[2] = pk2(v[4], v[5]); w[3] = pk2(v[6], v[7]);
                        *(u32x4*)(O + (size_t)r * ld + c) = w;
                    }
                }
            }
    }
};

struct SplitOrder {
    StaticOrder full; int nN, KT, KS;
    __device__ __forceinline__ void init(int N, int K, int G, int c, int KS_) { full.init(MP, N, G, c); nN = N / BM; KT = K / BK; KS = KS_; }
    __device__ __forceinline__ bool next(int i, Unit& u) const {
        const int L = i * full.G + full.c, nsp = (MS / BM) * nN * KS;
        if (L >= full.nwg + nsp) return false;
        const bool isfull = L < full.nwg;
        int pmf, pnf; full.map(isfull ? L : 0, pmf, pnf);
        const int s = isfull ? 0 : L - full.nwg, ks = s % KS, tile = s / KS, ntk = KT / KS;
        u = Unit{isfull ? pmf : MP / BM + tile / nN, isfull ? pnf : tile % nN, isfull ? 0 : ks * ntk, isfull ? 0 : ntk, isfull ? -1 : ks};
        return true;
    }
    __device__ __forceinline__ void a_ready(const Unit&) const {}
    __device__ __forceinline__ void done(const Unit&) const {}
};
struct EpiResid {
    static constexpr bool PERM = false, AFTER_DRAIN = false, MID = false;
    const float* base; float* out; float* slab;
    DI void operator()(const f32x4 (&acc)[2][2][4][2], const Unit& u, int wr, int wc, int fr, int fq) const {
        const int row0 = u.pm * BM + wr * 64 + fr, col0 = u.pn * BM + wc * 32 + 4 * fq;
        if (u.ks < 0) {
#pragma unroll
            for (int ai = 0; ai < 2; ++ai)
#pragma unroll
                for (int m = 0; m < 4; ++m) { const size_t off = (size_t)(row0 + ai * HALF + m * 16) * 2048 + col0;
#pragma unroll
                    for (int bj = 0; bj < 2; ++bj)
#pragma unroll
                        for (int n = 0; n < 2; ++n) { const f32x4 b = *(const f32x4*)(base + off + bj * HALF + n * 16); *(f32x4*)(out + off + bj * HALF + n * 16) = b + acc[ai][bj][m][n]; } }
        } else {
            float* sl = slab + (size_t)u.ks * ((size_t)MS * 2048) - (size_t)MP * 2048;
#pragma unroll
            for (int ai = 0; ai < 2; ++ai)
#pragma unroll
                for (int m = 0; m < 4; ++m) { const size_t off = (size_t)(row0 + ai * HALF + m * 16) * 2048 + col0;
#pragma unroll
                    for (int bj = 0; bj < 2; ++bj)
#pragma unroll
                        for (int n = 0; n < 2; ++n) *(f32x4*)(sl + off + bj * HALF + n * 16) = acc[ai][bj][m][n]; }
        }
    }
};
}
#define XB_TMO      128
#define XB_XCNT(j)  (256  + 64 * (j))
#define XB_XSUB(j)  (1280 + 64 * (j))
#define XB_XGEN(j)  (2304 + 64 * (j))
#define XB_TOP      3328
#define XB_TOPGEN   3392
#define XCD_BAR_WORDS 3456
#define XB_SPIN_CAP (1u << 18)

__device__ __forceinline__ unsigned xb_ld(unsigned* p)              { return __hip_atomic_load(p, __ATOMIC_RELAXED, __HIP_MEMORY_SCOPE_AGENT); }
__device__ __forceinline__ unsigned xb_add(unsigned* p, unsigned v) { return __hip_atomic_fetch_add(p, v, __ATOMIC_RELAXED, __HIP_MEMORY_SCOPE_AGENT); }
__device__ __forceinline__ unsigned xb_xcc_id() { return (unsigned)__builtin_amdgcn_s_getreg((3 << 11) | 20) & 0xFu; }
#define XB_SPIN(cond, bar) do { unsigned _sp = 0; while (cond) { __builtin_amdgcn_s_sleep(1); \
    if ((++_sp & 255u) == 0u) { if (xb_ld(&(bar)[XB_TMO])) break; if (_sp > XB_SPIN_CAP) { atomicAdd(&(bar)[XB_TMO], 1u); break; } } } } while (0)

struct XcdBarrier {
    unsigned* bar; unsigned x;
    volatile LAS unsigned* st;
};

__device__ __forceinline__ XcdBarrier xcd_barrier_post(unsigned* bar, volatile LAS unsigned* st) {
    XcdBarrier b; b.bar = bar; b.x = xb_xcc_id(); b.st = st;
    if (threadIdx.x == 0) (void)xb_add(&bar[XB_XCNT(b.x)], 1u);
    return b;
}
__device__ __forceinline__ void xcd_barrier_complete(unsigned* bar, unsigned x, unsigned& nloc, unsigned& nx) {
    const unsigned G = gridDim.x * gridDim.y * gridDim.z;
    unsigned sum, cnt, mine, sp = 0u;
    for (;;) {
        sum = 0u; cnt = 0u; mine = 0u;
#pragma unroll
        for (unsigned j = 0; j < 16; ++j) { const unsigned c = xb_ld(&bar[XB_XCNT(j)]); sum += c; cnt += (c > 0u) ? 1u : 0u; mine = (j == x) ? c : mine; }
        if (sum == G) break;
        __builtin_amdgcn_s_sleep(1);
        if ((++sp & 255u) == 0u) { if (xb_ld(&bar[XB_TMO])) break; if (sp > XB_SPIN_CAP) { atomicAdd(&bar[XB_TMO], 1u); break; } }
    }
    nloc = mine > 0u ? mine : 1u; nx = cnt > 0u ? cnt : 1u;
}

__device__ __forceinline__ void xcd_barrier(const XcdBarrier& b) {
    asm volatile("s_waitcnt vmcnt(0)" ::: "memory");
    __syncthreads();
    if (threadIdx.x == 0) {
        unsigned* bar = b.bar;
        __builtin_amdgcn_s_waitcnt(0);
        unsigned nloc = b.st[0], nx = b.st[1];
        if (nloc == 0u) { xcd_barrier_complete(bar, b.x, nloc, nx); b.st[0] = nloc; b.st[1] = nx; }
        const unsigned old = xb_add(&bar[XB_XSUB(b.x)], 1u);
        const unsigned gen = old / nloc;
        if (old + 1u == (gen + 1u) * nloc) {
            __builtin_amdgcn_fence(__ATOMIC_RELEASE, "agent");
            asm volatile("s_waitcnt vmcnt(0)" ::: "memory");
            const unsigned og = xb_add(&bar[XB_TOP], 1u);
            const unsigned tg = og / nx;
            if (og + 1u == (tg + 1u) * nx) xb_add(&bar[XB_TOPGEN], 1u);
            else XB_SPIN(xb_ld(&bar[XB_TOPGEN]) == tg, bar);
            __builtin_amdgcn_fence(__ATOMIC_ACQUIRE, "agent");
            xb_add(&bar[XB_XGEN(b.x)], 1u);
            asm volatile("s_waitcnt vmcnt(0)" ::: "memory");
        } else {
            XB_SPIN(xb_ld(&bar[XB_XGEN(b.x)]) == gen, bar);
            __builtin_amdgcn_fence(__ATOMIC_ACQUIRE, "agent");
            asm volatile("s_waitcnt vmcnt(0)" ::: "memory");
        }
    }
    __syncthreads();
}


struct Frame {
    LAS uchar* lds;
    int tid, lane, wave, G, bid;
    const float *x_p, *x_s, *ck, *cv, *clf, *st0, *norm1, *w_in, *b_fox, *lb_logits, *gnorm, *w_pa, *w_pb, *w_o, *norm2, *w1, *w2, *norm_f;
    float* out; uchar* ws;
};
template <class T> DI T* wsp(const Frame& F, size_t off) { return (T*)(F.ws + off); }
DI const float* xrow(const Frame& F, int row) { return row < MP ? F.x_p + (size_t)row * D_MODEL : F.x_s + (size_t)(row - MP) * D_MODEL; }

DI void p0_transpose_item(const float* W, int ldw, int K, bf16* WT, int nblk, int shift_from, int shift, LAS uchar* img, const FragAddr& fa, int item, int lane) {
    const int kb = item / nblk, nb = item % nblk, k0 = 64 * kb, n0 = 64 * nb, n0s = n0 + (n0 >= shift_from ? shift : 0);
    const float* src = W + (size_t)(k0 + (lane >> 4)) * ldw + n0s + 4 * (lane & 15);
    f32x4 r[16];
#pragma unroll
    for (int i = 0; i < 16; ++i) r[i] = *(const f32x4*)(src + (size_t)(4 * i) * ldw);
#pragma unroll
    for (int i = 0; i < 16; ++i) *(LAS u32x2*)(img + off_a((unsigned)(4 * i + (lane >> 4)), (unsigned)((lane & 15) >> 1)) + 8 * (lane & 1)) = (u32x2){pk2(r[i][0], r[i][1]), pk2(r[i][2], r[i][3])};
    bf16* dst = WT + (size_t)(n0 + (lane & 31)) * K + k0 + 8 * (lane >> 5);
#pragma unroll
    for (int c = 0; c < 2; ++c)
#pragma unroll
        for (int ks = 0; ks < 4; ++ks) { const bf16x8 v = frag_tr<false>(img, fa, 0, c, ks); *(bf16x8*)(dst + (size_t)(32 * c) * K + 16 * ks) = v; }
}
template <bool WITH_FL> DI void rms_row_bf16(const Frame& F, const float* xr, const float* g, bf16* orow, int row) {
    const f32x4* xv = (const f32x4*)xr + F.lane; const f32x4* gv = (const f32x4*)g + F.lane;
    f32x4 v[8]; float s = 0.f;
#pragma unroll
    for (int j = 0; j < 8; ++j) { v[j] = xv[64 * j]; s += (v[j][0] * v[j][0] + v[j][1] * v[j][1]) + (v[j][2] * v[j][2] + v[j][3] * v[j][3]); }
    const float rstd = 1.0f / sqrtf(wave_sum(s) * (1.0f / D_MODEL) + EPS);
    u32x2* o8 = (u32x2*)orow + F.lane;
#pragma unroll
    for (int j = 0; j < 8; ++j) { v[j] = v[j] * rstd * gv[64 * j]; o8[64 * j] = (u32x2){pk2(v[j][0], v[j][1]), pk2(v[j][2], v[j][3])}; }
    if (WITH_FL) {
        float mine = 0.f;
#pragma unroll
        for (int c = 0; c < 8; ++c) {
            float a = 0.f;
#pragma unroll
            for (int j = 0; j < 8; ++j) { const f32x4 w = *((const LAS f32x4*)(F.lds + RING_OFF) + c * 512 + 64 * j + F.lane); a += (v[j][0] * w[0] + v[j][1] * w[1]) + (v[j][2] * w[2] + v[j][3] * w[3]); }
            const float t = wave_sum(a); if (F.lane == c) mine = t;
            asm volatile("" ::: "memory");
        }
        if (F.lane < 8) {
            const float z = mine + F.b_fox[F.lane];
            const float ls = fminf(z, 0.f) - log1pf(expf(-fabsf(z)));
            wsp<float>(F, WS_LFB)[(size_t)row * 8 + F.lane] = ls;
            if (row < MP) F.out[OUT_LFP + (size_t)row * 8 + F.lane] = ls; else F.out[OUT_LFS + (size_t)(row - MP) * 8 + F.lane] = ls;
        }
    }
}
DI void p0_prologue(const Frame& F) {
    LAS uchar* img = F.lds + RING_OFF + F.wave * 16384;
    const FragAddr fa = make_frag_addr(F.lane);
    const int gw = F.bid * NWAVES + F.wave, NGW = F.G * NWAVES;
    { const int gid = F.bid * 512 + F.tid; if (gid < W1K) { const float a = F.lb_logits[gid], b = F.lb_logits[W1K + gid]; wsp<float>(F, WS_LB)[gid] = 1.0f / (1.0f + expf(b - a)); } }
    for (int idx = F.tid; idx < D_MODEL * 2; idx += NWAVES * 64) { const int k = idx >> 1, hf = idx & 1; const f32x4 w = *(const f32x4*)(F.w_in + (size_t)k * N_IN + COL_FL + 4 * hf);
        LAS float* t = (LAS float*)(F.lds + RING_OFF) + (4 * hf) * D_MODEL + k; t[0] = w[0]; t[D_MODEL] = w[1]; t[2 * D_MODEL] = w[2]; t[3 * D_MODEL] = w[3]; }
    __syncthreads();
    for (int m = gw; m < MROWS; m += NGW) rms_row_bf16<true>(F, xrow(F, m), F.norm1, wsp<bf16>(F, WS_H) + (size_t)m * D_MODEL, m);
    __syncthreads();
    constexpr int I_IN = (D_MODEL / 64) * (N_INP / 64), I_PA = (W1K / 64) * (D_MODEL / 64), I_O = (D_MODEL / 64) * (D_MODEL / 64), I_1 = (D_MODEL / 64) * (D_FF / 64), I_2 = (D_FF / 64) * (D_MODEL / 64);
    constexpr int NITEMS = I_IN + 2 * I_PA + I_O + I_1 + I_2;
    for (int it = gw; it < NITEMS; it += NGW) {
        int r = it;
        if (r < I_IN) { p0_transpose_item(F.w_in, N_IN, D_MODEL, wsp<bf16>(F, WS_WIN), N_INP / 64, COL_FL, 8, img, fa, r, F.lane); continue; } r -= I_IN;
        if (r < I_PA) { p0_transpose_item(F.w_pa, D_MODEL, W1K, wsp<bf16>(F, WS_WPA), D_MODEL / 64, 1 << 30, 0, img, fa, r, F.lane); continue; } r -= I_PA;
        if (r < I_PA) { p0_transpose_item(F.w_pb, D_MODEL, W1K, wsp<bf16>(F, WS_WPB), D_MODEL / 64, 1 << 30, 0, img, fa, r, F.lane); continue; } r -= I_PA;
        if (r < I_O) { p0_transpose_item(F.w_o, D_MODEL, D_MODEL, wsp<bf16>(F, WS_WO), D_MODEL / 64, 1 << 30, 0, img, fa, r, F.lane); continue; } r -= I_O;
        if (r < I_1) { p0_transpose_item(F.w1, D_FF, D_MODEL, wsp<bf16>(F, WS_W1), D_FF / 64, 1 << 30, 0, img, fa, r, F.lane); continue; } r -= I_1;
        p0_transpose_item(F.w2, D_MODEL, D_FF, wsp<bf16>(F, WS_W2), D_MODEL / 64, 1 << 30, 0, img, fa, r, F.lane);
    }
}

DI void scan_rows(const float* src, int n, float (&carry)[8], float* dst, size_t dstride, int j0, int lane) {
    for (int i0 = 0; i0 < n; i0 += 64) {
        const int j = i0 + lane; const bool ok = j < n;
        float v[8];
        { f32x4 a = {0.f, 0.f, 0.f, 0.f}, b = {0.f, 0.f, 0.f, 0.f}; if (ok) { a = *(const f32x4*)(src + (size_t)j * 8); b = *(const f32x4*)(src + (size_t)j * 8 + 4); }
          v[0] = a[0]; v[1] = a[1]; v[2] = a[2]; v[3] = a[3]; v[4] = b[0]; v[5] = b[1]; v[6] = b[2]; v[7] = b[3]; }
#pragma unroll
        for (int h = 0; h < 8; ++h) {
#pragma unroll
            for (int o = 1; o < 64; o <<= 1) { const float t = __shfl_up(v[h], o); if (lane >= o) v[h] += t; }
            v[h] += carry[h];
            carry[h] = __shfl(v[h], 63);
            if (ok) dst[(size_t)h * dstride + j0 + j] = v[h] * LOG2E;
        }
    }
}
DI void sum_rows(const float* src, int n, float (&tot)[8], int lane) {
    float a[8];
#pragma unroll
    for (int h = 0; h < 8; ++h) a[h] = 0.f;
#pragma unroll 1
    for (int j0 = 0; j0 < n; j0 += 512) {
        f32x4 x[8], y[8];
#pragma unroll
        for (int i = 0; i < 8; ++i) { const float* p = src + (size_t)(j0 + 64 * i + lane) * 8; x[i] = *(const f32x4*)p; y[i] = *(const f32x4*)(p + 4); }
#pragma unroll
        for (int i = 0; i < 8; ++i) { a[0] += x[i][0]; a[1] += x[i][1]; a[2] += x[i][2]; a[3] += x[i][3]; a[4] += y[i][0]; a[5] += y[i][1]; a[6] += y[i][2]; a[7] += y[i][3]; }
    }
#pragma unroll
    for (int h = 0; h < 8; ++h) tot[h] = wave_sum(a[h]);
}
DI void p2_scans(const Frame& F) {
    const int gw = F.bid * NWAVES + F.wave;
    if (gw >= (NB_P + NB_S) * 8) return;
    const int sq = gw >> 3, seg = gw & 7;
    float carry[8];
    const float* lfb = wsp<float>(F, WS_LFB);
    if (sq < NB_P) { const float* src = lfb + (size_t)sq * SEQ * 8;
        sum_rows(src, seg * 512, carry, F.lane);
        scan_rows(src + (size_t)seg * 512 * 8, 512, carry, wsp<float>(F, WS_C2P) + (size_t)sq * 8 * SEQ, SEQ, seg * 512, F.lane); }
    else { const int b = sq - NB_P; float* dst = wsp<float>(F, WS_C2S) + (size_t)b * 8 * SKV_S; const float* src = F.clf + (size_t)b * PAST * 8;
        sum_rows(src, seg * 512, carry, F.lane);
        scan_rows(src + (size_t)seg * 512 * 8, 512, carry, dst, SKV_S, seg * 512, F.lane);
        if (seg == 7) scan_rows(lfb + (size_t)(MP + b * T_S) * 8, T_S, carry, dst, SKV_S, PAST, F.lane); }
}

DI void unit_rc(int u, int& row0, int& head) { if (u < NU_P) { const int bh = u >> 7, c = u & 127; row0 = (bh >> 3) * SEQ + c * CHK; head = bh & 7; } else { const int su = u - NU_P; row0 = MP + (su >> 3) * T_S; head = su & 7; } }
constexpr int HG_QT = 0, HG_KT = 8192, HG_KP = 16384, HG_V = 24576, HG_SP = 32768;
template <bool WRITE_DEC> DI void hgrn_prep(const Frame& F, int u, int tl, LAS uchar* base) {
    int row0, head; unit_rc(u, row0, head);
    if (tl < 128) {
        const int d = tl;
        const float* lfp = wsp<float>(F, WS_LFA) + (size_t)row0 * W1K + head * DH + d; const bf16* qp = wsp<bf16>(F, WS_QA) + (size_t)row0 * W1K + head * DH + d;
        float lf[CHK], bb[CHK], q[CHK];
#pragma unroll
        for (int t = 0; t < CHK; ++t) { lf[t] = lfp[(size_t)t * W1K]; q[t] = __uint_as_float((unsigned)qp[(size_t)t * W1K] << 16); }
        float b = 0.f;
#pragma unroll
        for (int t = 0; t < CHK; ++t) { b += lf[t]; bb[t] = b; }
        const float bend = b;
#pragma unroll
        for (int t = 0; t < CHK; ++t) {
            const float k = 1.0f - fexp(lf[t]);
            const float qt = q[t] * fexp(bb[t]), kt = k * fexp(-bb[t]), kp = k * fexp(bend - bb[t]);
            const unsigned a = off_a((unsigned)t, (unsigned)(d >> 3)) + (unsigned)(d & 7) * 2u;
            *(LAS unsigned short*)(base + HG_QT + a) = (unsigned short)(pk2(qt, 0.f) & 0xffffu);
            *(LAS unsigned short*)(base + HG_KT + a) = (unsigned short)(pk2(kt, 0.f) & 0xffffu);
            *(LAS unsigned short*)(base + HG_KP + a) = (unsigned short)(pk2(kp, 0.f) & 0xffffu);
        }
        if (WRITE_DEC) wsp<float>(F, WS_DEC)[(size_t)u * DH + d] = fexp(bend);
    } else {
        const int t2 = tl - 128; const bf16* vp = wsp<bf16>(F, WS_VA) + (size_t)row0 * W1K + head * DH;
#pragma unroll
        for (int i = 0; i < 4; ++i) { const int idx = t2 + 128 * i, row = idx >> 4, ch = idx & 15;
            *(LAS u32x4*)(base + HG_V + off_a((unsigned)row, (unsigned)ch)) = *(const u32x4*)(vp + (size_t)row * W1K + ch * 8); }
    }
}
DI void p3_hgrn_local(const Frame& F) {
    const int hw = F.wave >> 2, wl = F.wave & 3, tl = F.tid & 255, lane = F.lane, h = lane >> 5;
    LAS uchar* base = F.lds + RING_OFF + hw * 65536;
    const FragAddr fa = make_frag_addr(lane);
    for (int it = F.bid; it < NU / 2; it += F.G) {
        const int u = 2 * it + hw;
        hgrn_prep<true>(F, u, tl, base);
        __syncthreads();
        float* ds = wsp<float>(F, WS_DS) + (size_t)u * (DH * DH);
        const int dt = wl;
        const bf16x8 a0 = frag_tr<false>(base + HG_KP, fa, 0, dt, 0), a1 = frag_tr<false>(base + HG_KP, fa, 0, dt, 1);
#pragma unroll
        for (int et = 0; et < 4; ++et) {
            f32x16 acc;
#pragma unroll
            for (int i = 0; i < 16; ++i) acc[i] = 0.f;
            acc = MFMA32(a0, frag_tr<false>(base + HG_V, fa, 0, et, 0), acc);
            acc = MFMA32(a1, frag_tr<false>(base + HG_V, fa, 0, et, 1), acc);
#pragma unroll
            for (int i = 0; i < 16; ++i) { const int d = 32 * dt + (i & 3) + 8 * (i >> 2) + 4 * h; ds[(size_t)d * DH + 32 * et + (lane & 31)] = acc[i]; }
        }
        __syncthreads();
    }
}
DI void p4_hgrn_scan(const Frame& F) {
    const int gid = F.bid * 512 + F.tid, NT = F.G * 512;
    const float* DSb = wsp<float>(F, WS_DS); const float* DEC = wsp<float>(F, WS_DEC); bf16* SP = wsp<bf16>(F, WS_SP);
    for (int ch = gid; ch < NB_P * NH * DH * (DH / 2); ch += NT) {
        const int bh = ch >> 13, d = (ch >> 6) & 127, e = (ch & 63) * 2;
        float s0 = 0.f, s1 = 0.f;
        const size_t eo = (size_t)d * DH + e;
#pragma unroll 1
        for (int c0 = 0; c0 < NCH; c0 += 16) {
            f32x2 dv[16]; float dc[16];
#pragma unroll
            for (int j = 0; j < 16; ++j) { const int u = bh * NCH + c0 + j; dv[j] = *(const f32x2*)(DSb + (size_t)u * (DH * DH) + eo); dc[j] = DEC[(size_t)u * DH + d]; }
#pragma unroll
            for (int j = 0; j < 16; ++j) { const int u = bh * NCH + c0 + j;
                *(unsigned*)(SP + (size_t)u * (DH * DH) + eo) = pk2(s0, s1);
                s0 = s0 * dc[j] + dv[j][0]; s1 = s1 * dc[j] + dv[j][1]; }
        }
        *(f32x2*)(F.out + OUT_SP + (size_t)bh * (DH * DH) + eo) = (f32x2){s0, s1};
    }
    for (int i = gid; i < NU_S * DH * DH / 4; i += NT) {
        const int su = i >> 12, r = i & 4095, d = r >> 5;
        const int u = NU_P + su;
        const f32x4 s0 = *(const f32x4*)(F.st0 + (size_t)i * 4), dv = *(const f32x4*)(DSb + (size_t)u * (DH * DH) + (size_t)r * 4); const float dc = DEC[(size_t)u * DH + d];
        *(f32x4*)(F.out + OUT_SS + (size_t)i * 4) = s0 * dc + dv;
    }
}
DI void p5_hgrn_out(const Frame& F) {
    const int hw = F.wave >> 2, wl = F.wave & 3, tl = F.tid & 255, lane = F.lane, h = lane >> 5, t = lane & 31;
    LAS uchar* base = F.lds + RING_OFF + hw * 65536;
    LAS float* red = (LAS float*)(F.lds + SCR_OFF) + hw * 128;
    const FragAddr fa = make_frag_addr(lane);
    for (int it = F.bid; it < NU / 2; it += F.G) {
        const int u = 2 * it + hw;
        int row0, head; unit_rc(u, row0, head);
        hgrn_prep<false>(F, u, tl, base);
        if (u < NU_P) {
            const bf16* sp = wsp<bf16>(F, WS_SP) + (size_t)u * (DH * DH);
#pragma unroll
            for (int i = 0; i < 8; ++i) { const int idx = tl + 256 * i, row = idx >> 4, ch = idx & 15;
                *(LAS u32x4*)(base + HG_SP + off_a((unsigned)row, (unsigned)ch)) = *(const u32x4*)(sp + (size_t)row * DH + ch * 8); }
        } else {
            const float* sp = F.st0 + (size_t)(u - NU_P) * (DH * DH);
#pragma unroll
            for (int i = 0; i < 16; ++i) { const int idx = tl + 256 * i, row = idx >> 5, c4 = idx & 31; const f32x4 v = *(const f32x4*)(sp + (size_t)row * DH + c4 * 4);
                *(LAS u32x2*)(base + HG_SP + off_a((unsigned)row, (unsigned)(c4 >> 1)) + 8 * (c4 & 1)) = (u32x2){pk2(v[0], v[1]), pk2(v[2], v[3])}; }
        }
        __syncthreads();
        const int et = wl;
        bf16x8 qf[8];
#pragma unroll
        for (int ks = 0; ks < 8; ++ks) qf[ks] = frag_row(base + HG_QT, fa, 0, ks);
        f32x16 at, o;
#pragma unroll
        for (int i = 0; i < 16; ++i) { at[i] = 0.f; o[i] = 0.f; }
#pragma unroll
        for (int ks = 0; ks < 8; ++ks) at = MFMA32(frag_row(base + HG_KT, fa, 0, ks), qf[ks], at);
#pragma unroll
        for (int i = 0; i < 16; ++i) { const int s = (i & 3) + 8 * (i >> 2) + 4 * h; at[i] = (s <= t) ? at[i] : 0.f; }
#pragma unroll
        for (int ks = 0; ks < 8; ++ks) o = MFMA32(frag_tr<false>(base + HG_SP, fa, 0, et, ks), qf[ks], o);
        o = MFMA32(frag_tr<true>(base + HG_V, fa, 0, et, 0), pack_acc(at, 0), o);
        o = MFMA32(frag_tr<true>(base + HG_V, fa, 0, et, 1), pack_acc(at, 1), o);
        float ss = 0.f;
#pragma unroll
        for (int i = 0; i < 16; ++i) ss += o[i] * o[i];
        ss += __shfl_xor(ss, 32);
        if (h == 0) red[wl * 32 + t] = ss;
        __syncthreads();
        const float tot = (red[t] + red[32 + t]) + (red[64 + t] + red[96 + t]);
        const float rstd = 1.0f / sqrtf(tot * (1.0f / DH) + EPS);
        const bf16* ga = wsp<bf16>(F, WS_GA) + (size_t)(row0 + t) * W1K + head * DH; bf16* oa = wsp<bf16>(F, WS_OA) + (size_t)(row0 + t) * W1K + head * DH;
#pragma unroll
        for (int g = 0; g < 4; ++g) {
            const int e0 = 32 * et + 8 * g + 4 * h;
            const f32x4 gn = *(const f32x4*)(F.gnorm + e0); const u32x2 gw2 = *(const u32x2*)(ga + e0);
            const float v0 = o[4 * g + 0] * rstd * gn[0] * bf_lo(gw2[0]), v1 = o[4 * g + 1] * rstd * gn[1] * bf_hi(gw2[0]), v2 = o[4 * g + 2] * rstd * gn[2] * bf_lo(gw2[1]), v3 = o[4 * g + 3] * rstd * gn[3] * bf_hi(gw2[1]);
            *(u32x2*)(oa + e0) = (u32x2){pk2(v0, v1), pk2(v2, v3)};
        }
        __syncthreads();
    }
}

template <bool QLDS> DI bool flash_qk(const bool MASK, const bf16x8 (&qf)[8], LAS uchar* qimg, LAS uchar* kimg, int R0, const f32x4 (&ckv)[4], float cq2, int kabs0, int qabs, float& m, float& l, f32x16 (&o)[4], bf16x8& pf0, bf16x8& pf1, int lane, const FragAddr& fa) {
    const int h = lane >> 5;
    f32x16 s;
#pragma unroll
    for (int i = 0; i < 16; ++i) s[i] = 0.f;
#pragma unroll
    for (int ks = 0; ks < 8; ++ks) s = MFMA32(frag_row(kimg, fa, R0, ks), QLDS ? frag_row(qimg, fa, 0, ks) : qf[ks], s);
    float mx = -INFINITY;
#pragma unroll
    for (int g = 0; g < 4; ++g) {
        const f32x4 ck = ckv[g];
#pragma unroll
        for (int e = 0; e < 4; ++e) {
            float v = s[4 * g + e] + (cq2 - ck[e]);
            if (MASK) { const int key = kabs0 + 8 * g + 4 * h + e; v = (key <= qabs) ? v : -INFINITY; }
            s[4 * g + e] = v; mx = fmaxf(mx, v);
        }
    }
    mx = fmaxf(mx, __shfl_xor(mx, 32));
    if (__all(mx < m - 150.f)) return false;
    if (__any(mx > m)) {
        const float mn = fmaxf(m, mx), alpha = fexp2(m - mn);
        m = mn; l *= alpha;
#pragma unroll
        for (int dt = 0; dt < 4; ++dt) o[dt] = o[dt] * alpha;
    }
    float ps = 0.f;
#pragma unroll
    for (int i = 0; i < 16; ++i) { const float p = fexp2(s[i] - m); s[i] = p; ps += p; }
    l += ps;
    pf0 = pack_acc(s, 0); pf1 = pack_acc(s, 1);
    return true;
}
DI void flash_pv(LAS uchar* vimg, int R0, const bf16x8& pf0, const bf16x8& pf1, f32x16 (&o)[4], const FragAddr& fa) {
#pragma unroll
    for (int dt = 0; dt < 4; ++dt) o[dt] = MFMA32(frag_tr<true>(vimg, fa, R0, dt, 0), pf0, o[dt]);
#pragma unroll
    for (int dt = 0; dt < 4; ++dt) o[dt] = MFMA32(frag_tr<true>(vimg, fa, R0, dt, 1), pf1, o[dt]);
}

DI void attn_prompt_unit(const Frame& F, int bh, int qb) {
    const int lane = F.lane, w = F.wave, wq = w & 3, wk = w >> 2, h = lane >> 5, c = lane & 31, tid = F.tid;
    const int b = bh >> 3, head = bh & 7;
    const FragAddr fa = make_frag_addr(lane);
    const bf16* Qg = wsp<bf16>(F, WS_QB) + (size_t)b * SEQ * W1K + head * DH;
    const bf16* Kg = wsp<bf16>(F, WS_KB) + (size_t)b * SEQ * W1K + head * DH;
    const bf16* Vg = wsp<bf16>(F, WS_VB) + (size_t)b * SEQ * W1K + head * DH;
    const float* c2 = wsp<float>(F, WS_C2P) + (size_t)bh * SEQ;
    const int q0 = qb * 128, qabs = q0 + 32 * wq + c, nit = qb + 1;
    bf16x8 qf[8];
#pragma unroll
    for (int ks = 0; ks < 8; ++ks) qf[ks] = *(const bf16x8*)(Qg + (size_t)qabs * W1K + 16 * ks + 8 * h);
    const float cq2 = c2[qabs];
    float m = -1e30f, l = 0.f; f32x16 o[4];
#pragma unroll
    for (int dt = 0; dt < 4; ++dt)
#pragma unroll
        for (int i = 0; i < 16; ++i) o[dt][i] = 0.f;
    u32x4 kr[4], vr[4]; f32x4 cr = {0.f, 0.f, 0.f, 0.f};
#define AP_LOAD(itx) do { _Pragma("unroll") for (int i = 0; i < 4; ++i) { const int idx = tid + 512 * i, key = idx >> 4, ch = idx & 15; const size_t go = (size_t)((itx) * 128 + key) * W1K + ch * 8; \
        kr[i] = *(const u32x4*)(Kg + go); vr[i] = *(const u32x4*)(Vg + go); } if (tid < 32) cr = *(const f32x4*)(c2 + (itx) * 128 + tid * 4); } while (0)
#define AP_WRITE(sx) do { LAS uchar* sb_ = F.lds + RING_OFF + (sx) * 65536; _Pragma("unroll") for (int i = 0; i < 4; ++i) { const int idx = tid + 512 * i, key = idx >> 4, ch = idx & 15; \
        const unsigned a = (unsigned)(key >> 6) * 16384u + off_a((unsigned)(key & 63), (unsigned)ch); *(LAS u32x4*)(sb_ + a) = kr[i]; *(LAS u32x4*)(sb_ + 32768 + a) = vr[i]; } if (tid < 32) *((LAS f32x4*)(F.lds + SCR_OFF + 1024) + (sx) * 32 + tid) = cr; } while (0)
    AP_LOAD(nit - 1); AP_WRITE((nit - 1) & 1);
    __syncthreads();
    for (int it = nit - 1; it >= 0; --it) {
        const bool more = it > 0;
        if (more) AP_LOAD(it - 1);
        LAS uchar* sb = F.lds + RING_OFF + (it & 1) * 65536;
        LAS uchar* kimg = sb + wk * 16384; LAS uchar* vimg = sb + 32768 + wk * 16384;
        const int kabs0 = it * 128 + wk * 64;
        bf16x8 pf0, pf1;
        const bool diag = (it == nit - 1);
#pragma unroll 1
        for (int R0 = 32; R0 >= 0; R0 -= 32) {
            f32x4 ckv[4];
            { const LAS float* cl = (const LAS float*)(F.lds + SCR_OFF + 1024) + (it & 1) * 128 + wk * 64 + R0 + 4 * h;
#pragma unroll
              for (int g = 0; g < 4; ++g) ckv[g] = *(const LAS f32x4*)(cl + 8 * g); }
            if (flash_qk<false>(diag, qf, nullptr, kimg, R0, ckv, cq2, kabs0 + R0, qabs, m, l, o, pf0, pf1, lane, fa)) flash_pv(vimg, R0, pf0, pf1, o, fa);
        }
        if (more) AP_WRITE((it - 1) & 1);
        __syncthreads();
    }
#undef AP_LOAD
#undef AP_WRITE
    LAS f32x4* xb = (LAS f32x4*)(F.lds + RING_OFF) + wq * (17 * 64);
    if (wk == 1) {
#pragma unroll
        for (int dt = 0; dt < 4; ++dt)
#pragma unroll
            for (int g = 0; g < 4; ++g) xb[(dt * 4 + g) * 64 + lane] = (f32x4){o[dt][4 * g], o[dt][4 * g + 1], o[dt][4 * g + 2], o[dt][4 * g + 3]};
        xb[16 * 64 + lane] = (f32x4){m, l, 0.f, 0.f};
    }
    __syncthreads();
    if (wk == 0) {
        const f32x4 ml = xb[16 * 64 + lane];
        const float mn = fmaxf(m, ml[0]), a0 = fexp2(m - mn), a1 = fexp2(ml[0] - mn);
        float lt = l * a0 + ml[1] * a1;
        lt += __shfl_xor(lt, 32);
        const float inv = 1.0f / lt;
        bf16* og = wsp<bf16>(F, WS_OB) + (size_t)(b * SEQ + qabs) * W1K + head * DH;
#pragma unroll
        for (int dt = 0; dt < 4; ++dt)
#pragma unroll
            for (int g = 0; g < 4; ++g) {
                const f32x4 p = xb[(dt * 4 + g) * 64 + lane];
                const float v0 = (o[dt][4 * g] * a0 + p[0] * a1) * inv, v1 = (o[dt][4 * g + 1] * a0 + p[1] * a1) * inv, v2 = (o[dt][4 * g + 2] * a0 + p[2] * a1) * inv, v3 = (o[dt][4 * g + 3] * a0 + p[3] * a1) * inv;
                *(u32x2*)(og + 32 * dt + 8 * g + 4 * h) = (u32x2){pk2(v0, v1), pk2(v2, v3)};
            }
    }
    __syncthreads();
}
DI void p6_attn_prompt(const Frame& F) {
#pragma unroll 1
    for (int j = 2 * F.bid; j < 2 * NB_P * NH * 16; j += ((j & 1) ? 2 * F.G - 1 : 1)) {
        const int item = j >> 1, bh = item >> 4, p = item & 15;
        attn_prompt_unit(F, bh, (j & 1) ? p : 31 - p);
    }
}

DI void cache_tile_to_image(const float* src, LAS uchar* img, int lrow, int lch) {
    const float* p = src + (size_t)lrow * (NH * DH) + lch * 4;
#pragma unroll
    for (int hf = 0; hf < 2; ++hf) {
        f32x4 r[8];
#pragma unroll
        for (int i = 0; i < 8; ++i) r[i] = __builtin_nontemporal_load((const f32x4*)(p + (size_t)(2 * (8 * hf + i)) * (NH * DH)));
#pragma unroll
        for (int i = 0; i < 8; ++i) { const int row = 2 * (8 * hf + i) + lrow;
            *(LAS u32x2*)(img + off_a((unsigned)row, (unsigned)(lch >> 1)) + 8 * (lch & 1)) = (u32x2){pk2(r[i][0], r[i][1]), pk2(r[i][2], r[i][3])}; }
    }
}
DI void attn_sample_unit(const Frame& F, int su) {
    const int lane = F.lane, w = F.wave, h = lane >> 5, c = lane & 31;
    const int b = su >> 3, head = su & 7;
    const FragAddr fa = make_frag_addr(lane);
    LAS uchar* kimg = F.lds + RING_OFF + w * 16384; LAS uchar* vimg = kimg + 8192;
    const float* c2 = wsp<float>(F, WS_C2S) + (size_t)su * SKV_S;
    const int rowq = MP + b * T_S + c;
    bf16x8 qf[8];
#pragma unroll
    for (int ks = 0; ks < 8; ++ks) qf[ks] = (bf16x8){0, 0, 0, 0, 0, 0, 0, 0};
    LAS uchar* qimg = F.lds + QIMG_OFF;
    { const int row = F.tid >> 4, ch = F.tid & 15;
      *(LAS u32x4*)(qimg + off_a((unsigned)row, (unsigned)ch)) = *(const u32x4*)(wsp<bf16>(F, WS_QB) + (size_t)(MP + b * T_S + row) * W1K + head * DH + ch * 8); }
    __syncthreads();
    const float cq2 = c2[PAST + c];
    float m = -1e30f, l = 0.f; f32x16 o[4];
#pragma unroll
    for (int dt = 0; dt < 4; ++dt)
#pragma unroll
        for (int i = 0; i < 16; ++i) o[dt][i] = 0.f;
    bf16x8 pf0, pf1;
    if (w == 0) {
        const bf16* kg = wsp<bf16>(F, WS_KB) + (size_t)(MP + b * T_S) * W1K + head * DH; const bf16* vg = wsp<bf16>(F, WS_VB) + (size_t)(MP + b * T_S) * W1K + head * DH;
#pragma unroll
        for (int i = 0; i < 8; ++i) { const int idx = lane + 64 * i, row = idx >> 4, ch = idx & 15;
            *(LAS u32x4*)(kimg + off_a((unsigned)row, (unsigned)ch)) = *(const u32x4*)(kg + (size_t)row * W1K + ch * 8);
            *(LAS u32x4*)(vimg + off_a((unsigned)row, (unsigned)ch)) = *(const u32x4*)(vg + (size_t)row * W1K + ch * 8); }
        f32x4 ckv[4];
#pragma unroll
        for (int g = 0; g < 4; ++g) ckv[g] = *(const f32x4*)(c2 + PAST + 8 * g + 4 * h);
        if (flash_qk<true>(true, qf, qimg, kimg, 0, ckv, cq2, 0, c, m, l, o, pf0, pf1, lane, fa)) flash_pv(vimg, 0, pf0, pf1, o, fa);
    }
    const float* kb = F.ck + ((size_t)b * PAST * NH + head) * DH; const float* vb = F.cv + ((size_t)b * PAST * NH + head) * DH;
    const int lrow = lane >> 5, lch = lane & 31;
    for (int jt = PAST / 32 - 1 - w; jt >= 0; jt -= NWAVES) {
        f32x4 ckv[4];
#pragma unroll
        for (int g = 0; g < 4; ++g) ckv[g] = *(const f32x4*)(c2 + 32 * jt + 8 * g + 4 * h);
        cache_tile_to_image(kb + (size_t)(32 * jt) * (NH * DH), kimg, lrow, lch);
        if (flash_qk<true>(false, qf, qimg, kimg, 0, ckv, cq2, 0, 0, m, l, o, pf0, pf1, lane, fa)) {
            cache_tile_to_image(vb + (size_t)(32 * jt) * (NH * DH), vimg, lrow, lch);
            flash_pv(vimg, 0, pf0, pf1, o, fa);
        }
    }
    LAS float* ms = (LAS float*)(F.lds + SCR_OFF);
    l += __shfl_xor(l, 32);
    if (h == 0) ms[w * 32 + c] = m;
    __syncthreads();
    float mg = ms[c];
#pragma unroll
    for (int j = 1; j < 8; ++j) mg = fmaxf(mg, ms[j * 32 + c]);
    const float a = fexp2(m - mg);
    if (h == 0) ms[256 + w * 32 + c] = l * a;
    LAS uchar* po = F.lds + RING_OFF + w * 16384;
#pragma unroll
    for (int dt = 0; dt < 4; ++dt)
#pragma unroll
        for (int g = 0; g < 4; ++g) { const unsigned chk = (unsigned)(8 * dt + 2 * g + h) ^ (unsigned)c;
            *(LAS f32x4*)(po + c * 512 + chk * 16) = (f32x4){o[dt][4 * g] * a, o[dt][4 * g + 1] * a, o[dt][4 * g + 2] * a, o[dt][4 * g + 3] * a}; }
    __syncthreads();
    float lt = 0.f;
#pragma unroll
    for (int j = 0; j < 8; ++j) lt += ms[256 + j * 32 + c];
    const float inv = 1.0f / lt;
    f32x4 s0 = {0.f, 0.f, 0.f, 0.f}, s1 = {0.f, 0.f, 0.f, 0.f};
#pragma unroll
    for (int j = 0; j < 8; ++j) { const LAS uchar* pj = F.lds + RING_OFF + j * 16384 + c * 512;
        s0 += *(const LAS f32x4*)(pj + (((unsigned)(4 * w + 2 * h) ^ (unsigned)c) * 16)); s1 += *(const LAS f32x4*)(pj + (((unsigned)(4 * w + 2 * h + 1) ^ (unsigned)c) * 16)); }
    s0 = s0 * inv; s1 = s1 * inv;
    u32x4 ow; ow[0] = pk2(s0[0], s0[1]); ow[1] = pk2(s0[2], s0[3]); ow[2] = pk2(s1[0], s1[1]); ow[3] = pk2(s1[2], s1[3]);
    *(u32x4*)(wsp<bf16>(F, WS_OB) + (size_t)rowq * W1K + head * DH + 16 * w + 8 * h) = ow;
    __syncthreads();
}
DI void p6_attn_sample(const Frame& F) { for (int su = F.bid; su < NB_S * NH; su += F.G) attn_sample_unit(F, su); }

DI void slab_row_sum(const Frame& F, const float* res, int srow, f32x4 (&v)[8]) {
    const f32x4* rv = (const f32x4*)res + F.lane;
#pragma unroll
    for (int j = 0; j < 8; ++j) v[j] = rv[64 * j];
#pragma unroll 2
    for (int ks = 0; ks < 8; ++ks) { const f32x4* sv = (const f32x4*)(wsp<float>(F, WS_T1) + ((size_t)ks * MS + srow) * D_MODEL) + F.lane;
#pragma unroll
        for (int j = 0; j < 8; ++j) v[j] += sv[64 * j]; }
}
DI void p_norm2(const Frame& F) {
    const int gw = F.bid * NWAVES + F.wave, NGW = F.G * NWAVES;
    for (int m = gw; m < MROWS; m += NGW) {
        float* x1r = wsp<float>(F, WS_X1) + (size_t)m * D_MODEL;
        f32x4 v[8];
        if (m < MP) { const f32x4* xv = (const f32x4*)x1r + F.lane;
#pragma unroll
            for (int j = 0; j < 8; ++j) v[j] = xv[64 * j]; }
        else { slab_row_sum(F, F.x_s + (size_t)(m - MP) * D_MODEL, m - MP, v);
#pragma unroll
            for (int j = 0; j < 8; ++j) ((f32x4*)x1r + F.lane)[64 * j] = v[j]; }
        float s = 0.f;
#pragma unroll
        for (int j = 0; j < 8; ++j) s += (v[j][0] * v[j][0] + v[j][1] * v[j][1]) + (v[j][2] * v[j][2] + v[j][3] * v[j][3]);
        const float rstd = 1.0f / sqrtf(wave_sum(s) * (1.0f / D_MODEL) + EPS);
        u32x2* o8 = (u32x2*)(wsp<bf16>(F, WS_H) + (size_t)m * D_MODEL) + F.lane; const f32x4* gv = (const f32x4*)F.norm2 + F.lane;
#pragma unroll
        for (int j = 0; j < 8; ++j) { const f32x4 hh = v[j] * rstd * gv[64 * j]; o8[64 * j] = (u32x2){pk2(hh[0], hh[1]), pk2(hh[2], hh[3])}; }
    }
}
DI void p_norm_final(const Frame& F) {
    const int gw = F.bid * NWAVES + F.wave, NGW = F.G * NWAVES;
    for (int m = gw; m < MROWS; m += NGW) {
        f32x4* xv = (f32x4*)(F.out + OUT_Y + (size_t)m * D_MODEL) + F.lane; const f32x4* gv = (const f32x4*)F.norm_f + F.lane;
        f32x4 v[8]; float s = 0.f;
        if (m < MP) {
#pragma unroll
            for (int j = 0; j < 8; ++j) v[j] = xv[64 * j]; }
        else slab_row_sum(F, wsp<float>(F, WS_X1) + (size_t)m * D_MODEL, m - MP, v);
#pragma unroll
        for (int j = 0; j < 8; ++j) s += (v[j][0] * v[j][0] + v[j][1] * v[j][1]) + (v[j][2] * v[j][2] + v[j][3] * v[j][3]);
        const float rstd = 1.0f / sqrtf(wave_sum(s) * (1.0f / D_MODEL) + EPS);
#pragma unroll
        for (int j = 0; j < 8; ++j) xv[64 * j] = v[j] * rstd * gv[64 * j];
    }
}

constexpr int N_PHASES = 14;
struct Args { const float* in[18]; float* out; uchar* ws; int ph_lo, ph_hi; };
__global__ void __launch_bounds__(NWAVES * 64, 2) fwd_kernel(Args args) {
    extern __shared__ __attribute__((aligned(16))) uchar lds_raw[];
    Frame F;
    F.lds = (LAS uchar*)lds_raw;
    F.tid = threadIdx.x; F.lane = F.tid & 63; F.wave = __builtin_amdgcn_readfirstlane(F.tid >> 6);
    F.G = gridDim.x; F.bid = blockIdx.x;
    F.x_p = args.in[0]; F.x_s = args.in[1]; F.ck = args.in[2]; F.cv = args.in[3]; F.clf = args.in[4]; F.st0 = args.in[5]; F.norm1 = args.in[6]; F.w_in = args.in[7]; F.b_fox = args.in[8];
    F.lb_logits = args.in[9]; F.gnorm = args.in[10]; F.w_pa = args.in[11]; F.w_pb = args.in[12]; F.w_o = args.in[13]; F.norm2 = args.in[14]; F.w1 = args.in[15]; F.w2 = args.in[16]; F.norm_f = args.in[17];
    F.out = args.out; F.ws = args.ws;
    for (int u = F.tid; u < (LDS_BYTES - LDSCTL_OFF) / 4; u += NWAVES * 64) ((LAS unsigned*)(F.lds + LDSCTL_OFF))[u] = 0u;
    __syncthreads();
    const int lo = args.ph_lo, hi = args.ph_hi;
    const bool multi = (hi - lo) > 1;
    XcdBarrier bar; bar.bar = (unsigned*)(F.ws + WS_CTL) + CW_BAR; bar.x = 0; bar.st = nullptr;
    if (multi) bar = xcd_barrier_post((unsigned*)(F.ws + WS_CTL) + CW_BAR, (volatile LAS unsigned*)(F.lds + MISC_OFF) + 8);
#ifndef PH_MASK
#define PH_MASK 0xffffffffu
#endif
#define IN(k) (((PH_MASK >> (k)) & 1u) && lo <= (k) && (k) < hi)
#define SEAM(k) do { if (IN(k) && IN((k) + 1)) xcd_barrier(bar); } while (0)
#ifndef DUP_MASK
#define DUP_MASK 0u
#endif
#define RUNPH(k, ...) if (IN(k)) { __VA_ARGS__ if ((DUP_MASK >> (k)) & 1u) { xcd_barrier(bar); __VA_ARGS__ } }
    LAS uchar* ring = F.lds + RING_OFF;

    RUNPH(0, { p0_prologue(F); }) SEAM(0);
    RUNPH(1, {
        pg8::Gemm g{wsp<bf16>(F, WS_H), wsp<bf16>(F, WS_WIN), MROWS, N_INP, D_MODEL}; pg8::StaticOrder S; S.init(MROWS, N_INP, F.G, F.bid);
        pg8::EpiInProj E{F.ws, F.out};
        pg8::gemm_phase<pg8::EpiInProj, pg8::StaticOrder, true, true>(ring, g, S, E);
    }) SEAM(1);
    RUNPH(2, { p2_scans(F); p3_hgrn_local(F); }) SEAM(2);
    RUNPH(3, { p4_hgrn_scan(F); }) SEAM(3);
    RUNPH(4, { p5_hgrn_out(F); }) SEAM(4);
    RUNPH(5, { p6_attn_prompt(F); }) SEAM(5);
    RUNPH(6, { p6_attn_sample(F); }) SEAM(6);
    RUNPH(7, {
        pg8::Gemm g{wsp<bf16>(F, WS_OA), wsp<bf16>(F, WS_WPA), MROWS, D_MODEL, W1K}; pg8::StaticOrder S; S.init(MROWS, D_MODEL, F.G, F.bid);
        pg8::EpiMix<0> E{wsp<bf16>(F, WS_G), wsp<float>(F, WS_T1), nullptr, 0};
        pg8::gemm_phase<pg8::EpiMix<0>, pg8::StaticOrder, true, true>(ring, g, S, E);
    }) SEAM(7);
    RUNPH(8, {
        pg8::Gemm g{wsp<bf16>(F, WS_OB), wsp<bf16>(F, WS_WPB), MROWS, D_MODEL, W1K}; pg8::StaticOrder S; S.init(MROWS, D_MODEL, F.G, F.bid);
        pg8::EpiMix<1> E{wsp<bf16>(F, WS_G), wsp<float>(F, WS_T1), wsp<bf16>(F, WS_MG), 0};
        pg8::gemm_phase<pg8::EpiMix<1>, pg8::StaticOrder, true, true>(ring, g, S, E);
    }) SEAM(8);
    RUNPH(9, {
        pg8::Gemm g{wsp<bf16>(F, WS_MG), wsp<bf16>(F, WS_WO), MROWS, D_MODEL, D_MODEL}; pg8::SplitOrder S; S.init(D_MODEL, D_MODEL, F.G, F.bid, 8);
        pg8::EpiResid E{F.x_p, wsp<float>(F, WS_X1), wsp<float>(F, WS_T1)};
        pg8::gemm_phase<pg8::EpiResid, pg8::SplitOrder, true, true>(ring, g, S, E);
    }) SEAM(9);
    RUNPH(10, { p_norm2(F); }) SEAM(10);
    RUNPH(11, {
        pg8::Gemm g{wsp<bf16>(F, WS_H), wsp<bf16>(F, WS_W1), MROWS, D_FF, D_MODEL}; pg8::StaticOrder S; S.init(MROWS, D_FF, F.G, F.bid);
        pg8::EpiMix<2> E{nullptr, nullptr, wsp<bf16>(F, WS_U), D_FF};
        pg8::gemm_phase<pg8::EpiMix<2>, pg8::StaticOrder, true, true>(ring, g, S, E);
    }) SEAM(11);
    RUNPH(12, {
        pg8::Gemm g{wsp<bf16>(F, WS_U), wsp<bf16>(F, WS_W2), MROWS, D_MODEL, D_FF}; pg8::SplitOrder S; S.init(D_MODEL, D_FF, F.G, F.bid, 8);
        pg8::EpiResid E{wsp<float>(F, WS_X1), F.out + OUT_Y, wsp<float>(F, WS_T1)};
        pg8::gemm_phase<pg8::EpiResid, pg8::SplitOrder, true, true>(ring, g, S, E);
    }) SEAM(12);
    RUNPH(13, { p_norm_final(F); })
#undef IN
#undef SEAM
}

#ifndef MK_ONE_LAUNCH
#define MK_ONE_LAUNCH 1
#endif
extern "C" void kernel_launch(void* const* d_in, const int* in_sizes, int n_in, void* d_out, int out_size, void* d_ws, size_t ws_size, hipStream_t stream) {
    static int grid = 0;
    if (grid == 0) {
        if (n_in != 18 || (size_t)out_size != OUT_END || ws_size < WS_END) { fprintf(stderr, "kernel_launch: unexpected sizes: n_in %d out %d ws %zu (need out %zu ws %zu)\n", n_in, out_size, ws_size, (size_t)OUT_END, (size_t)WS_END); grid = -1; return; }
        int dev = 0, cus = 0, per_cu = 0;
        if (hipGetDevice(&dev) != hipSuccess || hipDeviceGetAttribute(&cus, hipDeviceAttributeMultiprocessorCount, dev) != hipSuccess) { grid = -1; return; }
        if (hipFuncSetAttribute((const void*)fwd_kernel, hipFuncAttributeMaxDynamicSharedMemorySize, LDS_BYTES) != hipSuccess) { fprintf(stderr, "kernel_launch: hipFuncSetAttribute failed\n"); grid = -1; return; }
        if (hipOccupancyMaxActiveBlocksPerMultiprocessor(&per_cu, (const void*)fwd_kernel, NWAVES * 64, LDS_BYTES) != hipSuccess || per_cu < 1)
            fprintf(stderr, "kernel_launch: note: occupancy query reports %d workgroups per CU\n", per_cu);
        (void)hipGetLastError();
        grid = cus;
    }
    if (grid < 0) return;
    if (hipMemsetAsync((char*)d_ws + WS_CTL, 0, CTL_ZERO_BYTES, stream) != hipSuccess) { fprintf(stderr, "kernel_launch: memset failed\n"); return; }
    Args a{};
    for (int i = 0; i < 18; ++i) a.in[i] = (const float*)d_in[i];
    a.out = (float*)d_out; a.ws = (uchar*)d_ws;
#if MK_ONE_LAUNCH
    a.ph_lo = 0; a.ph_hi = N_PHASES;
    hipLaunchKernelGGL(fwd_kernel, dim3(grid), dim3(NWAVES * 64), LDS_BYTES, stream, a);
#else
    for (int p = 0; p < N_PHASES; ++p) { a.ph_lo = p; a.ph_hi = p + 1; hipLaunchKernelGGL(fwd_kernel, dim3(grid), dim3(NWAVES * 64), LDS_BYTES, stream, a); }
#endif
    const hipError_t le = hipPeekAtLastError();
    if (le != hipSuccess) fprintf(stderr, "kernel_launch: launch failed: %s\n", hipGetErrorName(le));
}
```

```cpp
#include <hip/hip_runtime.h>
#include <cstdio>
#include <cstdint>

constexpr int D_MODEL = 2048, SEQ = 4096, NB_P = 2, NB_S = 32, T_S = 32, PAST = 4096;
constexpr int MP = NB_P * SEQ;
constexpr int MS = NB_S * T_S;
constexpr int MROWS = MP + MS;
constexpr int NH = 8, DH = 128, W1K = 1024;
constexpr int D_FF = 8192;
constexpr int N_IN = 11272;
constexpr int N_INP = 11264;
constexpr int COL_FL = 7168;
constexpr int CHK = 32;
constexpr int NCH = SEQ / CHK;
constexpr int NU_P = NB_P * NH * NCH;
constexpr int NU_S = NB_S * NH;
constexpr int NU = NU_P + NU_S;
constexpr int SKV_S = PAST + T_S;
constexpr float EPS = 1e-6f;
constexpr float LOG2E = 1.4426950408889634f;
constexpr float QSCALE = 0.08838834764831845f * LOG2E;

#define GAS __attribute__((address_space(1)))
#define LAS __attribute__((address_space(3)))
#define DI __device__ __forceinline__
typedef unsigned short bf16;
typedef unsigned char uchar;
typedef short bf16x8 __attribute__((ext_vector_type(8)));
typedef short s16x4 __attribute__((ext_vector_type(4)));
typedef float f32x2 __attribute__((ext_vector_type(2)));
typedef float f32x4 __attribute__((ext_vector_type(4)));
typedef float f32x16 __attribute__((ext_vector_type(16)));
typedef unsigned u32x2 __attribute__((ext_vector_type(2)));
typedef unsigned u32x4 __attribute__((ext_vector_type(4)));
typedef __bf16 nbf2 __attribute__((ext_vector_type(2)));

DI unsigned pk2(float lo, float hi) { f32x2 x = {lo, hi}; nbf2 y = __builtin_convertvector(x, nbf2); return __builtin_bit_cast(unsigned, y); }
DI float bf_lo(unsigned u) { return __uint_as_float(u << 16); }
DI float bf_hi(unsigned u) { return __uint_as_float(u & 0xffff0000u); }
DI float fexp2(float x) { return __builtin_amdgcn_exp2f(x); }
DI float fexp(float x) { return __builtin_amdgcn_exp2f(x * LOG2E); }
DI float frcp(float x) { return __builtin_amdgcn_rcpf(x); }
DI float flog(float x) { return __builtin_amdgcn_logf(x) * 0.6931471805599453f; }
DI float fsigmoid(float x) { return frcp(1.0f + fexp(-x)); }
DI float fsilu(float x) { return x * fsigmoid(x); }
DI float wave_sum(float v) {
#pragma unroll
    for (int o = 1; o < 64; o <<= 1) v += __shfl_xor(v, o);
    return v;
}
#define MFMA32(a, b, c) __builtin_amdgcn_mfma_f32_32x32x16_bf16((a), (b), (c), 0, 0, 0)

DI unsigned off_a(unsigned row, unsigned ch) { return 2048u * (row >> 3) + 512u * (ch >> 2) + 64u * (row & 7u) + 16u * ((ch & 3u) ^ ((row >> 2) & 3u)); }
struct FragAddr { unsigned row_e, row_o, trn0, trn1, trp0, trp1; };
DI FragAddr make_frag_addr(int lane) {
    FragAddr a; const unsigned r = lane & 31, h = lane >> 5, blk = (lane >> 4) & 1, q = (lane & 15) >> 2, p = lane & 3;
    a.row_e = off_a(r, h); a.row_o = off_a(r, 2 + h);
    const unsigned ch = 2 * blk + (p >> 1);
    a.trn0 = off_a(8 * h + q, ch) + 8 * (p & 1); a.trn1 = off_a(8 * h + q + 4, ch) + 8 * (p & 1);
    a.trp0 = off_a(4 * h + q, ch) + 8 * (p & 1); a.trp1 = off_a(4 * h + q + 8, ch) + 8 * (p & 1);
    return a;
}
DI bf16x8 frag_row(LAS uchar* img, const FragAddr& fa, int R0, int s) { return *(LAS bf16x8*)(img + ((s & 1) ? fa.row_o : fa.row_e) + 256 * R0 + 512 * (s >> 1)); }
template <bool PERM> DI bf16x8 frag_tr(LAS uchar* img, const FragAddr& fa, int K0, int c, int ks) {
    const int imm = 256 * K0 + 4096 * ks + 512 * c;
    const s16x4 lo = __builtin_amdgcn_ds_read_tr16_b64_v4i16((LAS s16x4*)(img + (PERM ? fa.trp0 : fa.trn0) + imm));
    const s16x4 hi = __builtin_amdgcn_ds_read_tr16_b64_v4i16((LAS s16x4*)(img + (PERM ? fa.trp1 : fa.trn1) + imm));
    return (bf16x8){lo[0], lo[1], lo[2], lo[3], hi[0], hi[1], hi[2], hi[3]};
}
DI bf16x8 pack_acc(const f32x16& x, int s) {
    u32x4 p;
    p[0] = pk2(x[8 * s + 0], x[8 * s + 1]); p[1] = pk2(x[8 * s + 2], x[8 * s + 3]); p[2] = pk2(x[8 * s + 4], x[8 * s + 5]); p[3] = pk2(x[8 * s + 6], x[8 * s + 7]);
    return __builtin_bit_cast(bf16x8, p);
}

constexpr size_t MiB = 1u << 20;
constexpr size_t WS_CTL = 0, CTL_ZERO_BYTES = 1 * MiB;
constexpr size_t WS_WIN = 2 * MiB;
constexpr size_t WS_WP = 46 * MiB;
constexpr size_t WS_WO = 54 * MiB;
constexpr size_t WS_W1 = 62 * MiB;
constexpr size_t WS_W2 = 94 * MiB;
constexpr size_t WS_H = 126 * MiB;
constexpr size_t WS_QA = 162 * MiB, WS_VA = 180 * MiB, WS_GA = 198 * MiB, WS_QB = 216 * MiB, WS_KB = 234 * MiB, WS_VB = 252 * MiB;
constexpr size_t WS_LFA = 270 * MiB;
constexpr size_t WS_G = 306 * MiB;
constexpr size_t WS_LFB = 378 * MiB;
constexpr size_t WS_LB = 379 * MiB;
constexpr size_t WS_C2P = 380 * MiB;
constexpr size_t WS_C2S = 381 * MiB;
constexpr size_t WS_QN = 379 * MiB + 65536;
constexpr size_t WS_DEC = 386 * MiB;
constexpr size_t WS_DS = 388 * MiB;
constexpr size_t WS_SP = 532 * MiB;
constexpr size_t WS_OAB = 596 * MiB;
constexpr size_t WS_T1 = 632 * MiB;
constexpr size_t WS_MG = 704 * MiB;
constexpr size_t WS_X1 = 740 * MiB;
constexpr size_t WS_U = 812 * MiB;
constexpr size_t WS_END = 956 * MiB;
constexpr int CW_BAR = 4096;
constexpr int CW_KMAX = 16384;
constexpr size_t OUT_Y = 0, OUT_KP = (size_t)MROWS * 2048, OUT_VP = OUT_KP + (size_t)MP * 1024, OUT_LFP = OUT_VP + (size_t)MP * 1024, OUT_SP = OUT_LFP + (size_t)MP * 8,
                 OUT_KS = OUT_SP + (size_t)NB_P * NH * 128 * 128, OUT_VS = OUT_KS + (size_t)MS * 1024, OUT_LFS = OUT_VS + (size_t)MS * 1024, OUT_SS = OUT_LFS + (size_t)MS * 8,
                 OUT_END = OUT_SS + (size_t)NB_S * NH * 128 * 128;
constexpr int NWAVES = 8;
constexpr int RING_OFF = 0, RING_BYTES = 131072;
constexpr int LDSCTL_OFF = RING_BYTES, MISC_OFF = LDSCTL_OFF + 320;
constexpr int SCR_OFF = RING_BYTES + 1024;
constexpr int QIMG_OFF = SCR_OFF + 8192;
constexpr int LDS_BYTES = 163840;

#define RLX_AGENT __ATOMIC_RELAXED, __HIP_MEMORY_SCOPE_AGENT
namespace pg8 {
#define PG8_LAS __attribute__((address_space(3)))
typedef unsigned short bf16_t;
typedef short bf16x8 __attribute__((ext_vector_type(8)));
typedef float f32x4 __attribute__((ext_vector_type(4)));
typedef unsigned u32x4 __attribute__((ext_vector_type(4)));
constexpr int BM = 256, BK = 64, HALF = 128, HTB = HALF * BK * 2  , STAGE_BYTES = 8 * HTB, NXCD = 8, WGM = 8;

__host__ __device__ __forceinline__ int lds_byte(int r, int c) { const int st = (r >> 4) * 2 + (c >> 5), rr = r & 15, cc = c & 31, ob = rr * 64 + cc * 2; return st * 1024 + (ob ^ (((ob >> 9) & 1) << 5)); }
__host__ __device__ __forceinline__ void stage_rc(int b, int& R, int& C) { const int st = b / 1024, sb = b % 1024, swz = sb ^ (((sb >> 9) & 1) << 5); R = (st >> 1) * 16 + swz / 64; C = (st & 1) * 32 + (swz % 64) / 2; }
__host__ __device__ __forceinline__ int perm32(int rho) { const int n = rho >> 4, i = rho & 15; return 8 * (i >> 2) + 4 * n + (i & 3); }

struct Unit { int pm, pn, k0, nt, ks; };
struct Gemm { const bf16_t* A; const bf16_t* Bt; int M, N, K; };

struct StaticOrder {
    int nM, nN, nwg, G, c;
    __host__ __device__ __forceinline__ void init(int M, int N, int G_, int c_) { nM = M / BM; nN = N / BM; nwg = nM * nN; G = G_; c = c_; }
    __host__ __device__ __forceinline__ void map(int wgid, int& pm, int& pn) const {
        { const int q = nwg / NXCD, r = nwg % NXCD, xcd = wgid % NXCD, off = wgid / NXCD; wgid = (xcd < r ? xcd * (q + 1) : r * (q + 1) + (xcd - r) * q) + off; }
        const int nig = WGM * nN, gid = wgid / nig, fm = gid * WGM, gsz = (nM - fm) < WGM ? (nM - fm) : WGM;
        pm = fm + ((wgid % nig) % gsz); pn = (wgid % nig) / gsz;
    }
    __host__ __device__ __forceinline__ bool next(int i, Unit& u) const {
        const long L = (long)i * G + c; if (L >= nwg) return false;
        int pm, pn; map((int)L, pm, pn);
        u = Unit{pm, pn, 0, 0, -1}; return true;
    }
    __device__ __forceinline__ void a_ready(const Unit&) const {}
    __device__ __forceinline__ void done(const Unit&) const {}
};


template <class Epi, class Sched, bool ALIGN_EPI = false, bool SP2 = false>
__device__ __forceinline__ void gemm_phase(PG8_LAS unsigned char* lds, const Gemm g, const Sched& S, const Epi& E) {
    const int tid = threadIdx.x, wid = __builtin_amdgcn_readfirstlane(tid >> 6), lane = tid & 63, wr = wid >> 2, wc = wid & 3, fr = lane & 15, fq = lane >> 4;
    const int K = g.K;
    unsigned voffA[2], voffB[2];
#pragma unroll
    for (int i = 0; i < 2; ++i) { int R, C; stage_rc(tid * 16 + i * 8192, R, C); const int Rb = Epi::PERM ? ((R & ~31) + perm32(R & 31)) : R;
        voffA[i] = (unsigned)(R * K + C) * 2u; voffB[i] = (unsigned)(Rb * K + C) * 2u; }
    const size_t kstep = (size_t)(BK * 2);
    const size_t hstep = (size_t)HALF * K * 2;
    const size_t tstep = 2 * hstep;
    const unsigned ldsw = (unsigned)wid * 1024u;
    const int aoff = lds_byte(wr * 64 + fr, fq * 8), boff = lds_byte(wc * 32 + fr, fq * 8);
#define PG8_SA(b, h) (((b) * 2 + (h)) * HTB)
#define PG8_SB(b, h) ((4 + (b) * 2 + (h)) * HTB)
#define PG8_STAGE(bufoff, gbase, voff) do { _Pragma("unroll") for (int _i = 0; _i < 2; ++_i) \
        __builtin_amdgcn_global_load_lds((const unsigned*)((const char*)(gbase) + (voff)[_i]), (PG8_LAS unsigned*)(lds + (bufoff) + ldsw + _i * 8192), 16, 0, 0); } while (0)
#define PG8_LDA(dst, b, h) do { _Pragma("unroll") for (int m = 0; m < 4; ++m) _Pragma("unroll") for (int k = 0; k < 2; ++k) dst[m][k] = *(const PG8_LAS bf16x8*)(lds + PG8_SA(b, h) + aoff + m * 2048 + k * 1024); } while (0)
#define PG8_LDB(dst, b, h) do { _Pragma("unroll") for (int n = 0; n < 2; ++n) _Pragma("unroll") for (int k = 0; k < 2; ++k) dst[n][k] = *(const PG8_LAS bf16x8*)(lds + PG8_SB(b, h) + boff + n * 2048 + k * 1024); } while (0)
#define PG8_MMA(ai, bj, At, Bt) do { __builtin_amdgcn_s_setprio(1); _Pragma("unroll") for (int m = 0; m < 4; ++m) _Pragma("unroll") for (int n = 0; n < 2; ++n) _Pragma("unroll") for (int k = 0; k < 2; ++k) \
        acc[ai][bj][m][n] = __builtin_amdgcn_mfma_f32_16x16x32_bf16(Bt[n][k], At[m][k], acc[ai][bj][m][n], 0, 0, 0); __builtin_amdgcn_s_setprio(0); } while (0)
#define PG8_WAIT_V(n) asm volatile("s_waitcnt vmcnt(" #n ")" ::: "memory")
#define PG8_WAIT_L(n) asm volatile("s_waitcnt lgkmcnt(" #n ")" ::: "memory")
#define PG8_BAR __builtin_amdgcn_s_barrier()
#define PG8_SCHED __builtin_amdgcn_sched_barrier(0)
    Unit cur, nxt; int ui = 0;
    if (!S.next(0, cur)) return;
    f32x4 acc[2][2][4][2];
#pragma unroll
    for (int a = 0; a < 2; ++a)
#pragma unroll
        for (int b = 0; b < 2; ++b)
#pragma unroll
            for (int m = 0; m < 4; ++m)
#pragma unroll
                for (int n = 0; n < 2; ++n) acc[a][b][m][n] = (f32x4){0.f, 0.f, 0.f, 0.f};
    bf16x8 At[4][2], B0[2][2], B1[2][2];
    const char* cA = (const char*)g.A + (size_t)cur.pm * tstep + (size_t)cur.k0 * kstep; const char* cB = (const char*)g.Bt + (size_t)cur.pn * tstep + (size_t)cur.k0 * kstep;
    S.a_ready(cur);
    if constexpr (SP2) {
        PG8_STAGE(PG8_SB(0, 0), cB, voffB); PG8_STAGE(PG8_SB(0, 1), cB + hstep, voffB); PG8_STAGE(PG8_SA(0, 0), cA, voffA); PG8_STAGE(PG8_SA(0, 1), cA + hstep, voffA);
        if (wr == 1) PG8_BAR;
        PG8_WAIT_V(2); PG8_BAR;
        PG8_STAGE(PG8_SB(1, 0), cB + kstep, voffB); PG8_STAGE(PG8_SA(1, 0), cA + kstep, voffA); PG8_STAGE(PG8_SB(1, 1), cB + hstep + kstep, voffB);
        PG8_WAIT_V(6); PG8_BAR;
    } else {
        PG8_STAGE(PG8_SB(0, 0), cB, voffB); PG8_STAGE(PG8_SA(0, 0), cA, voffA); PG8_STAGE(PG8_SB(0, 1), cB + hstep, voffB); PG8_STAGE(PG8_SA(0, 1), cA + hstep, voffA);
        if (wr == 1) PG8_BAR;
        PG8_WAIT_V(4); PG8_BAR;
        PG8_STAGE(PG8_SB(1, 0), cB + kstep, voffB); PG8_STAGE(PG8_SA(1, 0), cA + kstep, voffA); PG8_STAGE(PG8_SB(1, 1), cB + hstep + kstep, voffB);
        PG8_WAIT_V(6); PG8_BAR;
    }
    for (;;) {
        const bool has_next = S.next(ui + 1, nxt);
        const char* nA = has_next ? (const char*)g.A + (size_t)nxt.pm * tstep + (size_t)nxt.k0 * kstep : cA; const char* nB = has_next ? (const char*)g.Bt + (size_t)nxt.pn * tstep + (size_t)nxt.k0 * kstep : cB;
        const int nt = cur.nt ? cur.nt : K / BK;
        for (int t = 0; t < nt; t += 2) {
            if constexpr (Epi::MID) { if (t == E.tmid(cur)) E.mid(acc, cur, wr, wc, fr, fq); }
            const bool last = (t == nt - 2);
            const char* a1 = cA + (size_t)(t + 1) * kstep;
            const char* a2 = last ? nA : cA + (size_t)(t + 2) * kstep; const char* b2 = last ? nB : cB + (size_t)(t + 2) * kstep;
            const char* a3 = a2 + kstep; const char* b3 = b2 + kstep;
            if (last && has_next) S.a_ready(nxt);
            if constexpr (SP2) {
            PG8_LDB(B0, 0, 0); PG8_LDB(B1, 0, 1); PG8_SCHED; PG8_LDA(At, 0, 0); PG8_STAGE(PG8_SA(1, 1), a1 + hstep, voffA);
            PG8_WAIT_V(8); PG8_WAIT_L(0); PG8_BAR; PG8_MMA(0, 0, At, B0); PG8_MMA(0, 1, At, B1); PG8_BAR; PG8_SCHED;
            PG8_LDA(At, 0, 1); PG8_STAGE(PG8_SB(0, 0), b2, voffB); PG8_STAGE(PG8_SB(0, 1), b2 + hstep, voffB); PG8_STAGE(PG8_SA(0, 0), a2, voffA);
            PG8_WAIT_V(8); PG8_WAIT_L(0); PG8_BAR; PG8_MMA(1, 0, At, B0); PG8_MMA(1, 1, At, B1); PG8_BAR; PG8_SCHED;
            PG8_LDB(B0, 1, 0); PG8_LDB(B1, 1, 1); PG8_SCHED; PG8_LDA(At, 1, 0); PG8_STAGE(PG8_SA(0, 1), a2 + hstep, voffA);
            PG8_WAIT_V(8); PG8_WAIT_L(0); PG8_BAR; PG8_MMA(0, 0, At, B0); PG8_MMA(0, 1, At, B1); PG8_BAR; PG8_SCHED;
            PG8_LDA(At, 1, 1); PG8_STAGE(PG8_SB(1, 0), b3, voffB); PG8_STAGE(PG8_SB(1, 1), b3 + hstep, voffB); PG8_STAGE(PG8_SA(1, 0), a3, voffA);
            PG8_WAIT_V(8); PG8_WAIT_L(0); PG8_BAR; PG8_MMA(1, 0, At, B0); PG8_MMA(1, 1, At, B1); PG8_BAR; PG8_SCHED;
            } else {
            PG8_LDB(B0, 0, 0); PG8_SCHED; PG8_LDA(At, 0, 0); PG8_STAGE(PG8_SA(1, 1), a1 + hstep, voffA);
            PG8_WAIT_L(8); PG8_BAR; PG8_WAIT_L(0); PG8_MMA(0, 0, At, B0); PG8_BAR; PG8_SCHED;
            PG8_LDB(B1, 0, 1); PG8_STAGE(PG8_SB(0, 0), b2, voffB);
            PG8_BAR; PG8_WAIT_L(0); PG8_MMA(0, 1, At, B1); PG8_BAR;
            PG8_LDA(At, 0, 1); PG8_STAGE(PG8_SA(0, 0), a2, voffA);
            PG8_BAR; PG8_WAIT_L(0); PG8_MMA(1, 0, At, B0); PG8_BAR; PG8_SCHED;
            PG8_STAGE(PG8_SB(0, 1), b2 + hstep, voffB);
            PG8_WAIT_V(6); PG8_BAR; PG8_MMA(1, 1, At, B1); PG8_BAR;
            PG8_LDB(B0, 1, 0); PG8_SCHED; PG8_LDA(At, 1, 0); PG8_STAGE(PG8_SA(0, 1), a2 + hstep, voffA);
            PG8_WAIT_L(8); PG8_BAR; PG8_WAIT_L(0); PG8_MMA(0, 0, At, B0); PG8_BAR; PG8_SCHED;
            PG8_LDB(B1, 1, 1); PG8_STAGE(PG8_SB(1, 0), b3, voffB);
            PG8_BAR; PG8_WAIT_L(0); PG8_MMA(0, 1, At, B1); PG8_BAR;
            PG8_LDA(At, 1, 1); PG8_STAGE(PG8_SA(1, 0), a3, voffA);
            PG8_BAR; PG8_WAIT_L(0); PG8_MMA(1, 0, At, B0); PG8_BAR; PG8_SCHED;
            PG8_STAGE(PG8_SB(1, 1), b3 + hstep, voffB);
            PG8_WAIT_V(6); PG8_BAR; PG8_MMA(1, 1, At, B1); PG8_BAR;
            }
        }
        if constexpr (ALIGN_EPI) { if (wr == 0) PG8_BAR; }
        if constexpr (!Epi::AFTER_DRAIN) { E(acc, cur, wr, wc, fr, fq); S.done(cur); }
        if (!has_next) break;
#pragma unroll
        for (int a = 0; a < 2; ++a)
#pragma unroll
            for (int b = 0; b < 2; ++b)
#pragma unroll
                for (int m = 0; m < 4; ++m)
#pragma unroll
                    for (int n = 0; n < 2; ++n) acc[a][b][m][n] = (f32x4){0.f, 0.f, 0.f, 0.f};
        cur = nxt; cA = nA; cB = nB; ++ui;
        if constexpr (ALIGN_EPI) { if (wr == 1) PG8_BAR; }
    }
    PG8_WAIT_V(0);
    if constexpr (!ALIGN_EPI) { if (wr == 0) PG8_BAR; }
    PG8_BAR;
    if constexpr (Epi::AFTER_DRAIN) { E.fused(acc, cur, wr, wc, fr, fq, lds, wid, lane); S.done(cur); }
#undef PG8_SA
#undef PG8_SB
#undef PG8_STAGE
#undef PG8_LDA
#undef PG8_LDB
#undef PG8_MMA
#undef PG8_WAIT_V
#undef PG8_WAIT_L
#undef PG8_BAR
#undef PG8_SCHED
}
}

namespace pg8 {
DI void unpack8(const u32x4 w, float (&f)[8]) { f[0] = bf_lo(w[0]); f[1] = bf_hi(w[0]); f[2] = bf_lo(w[1]); f[3] = bf_hi(w[1]); f[4] = bf_lo(w[2]); f[5] = bf_hi(w[2]); f[6] = bf_lo(w[3]); f[7] = bf_hi(w[3]); }

struct EpiInProj {
    static constexpr bool PERM = true, AFTER_DRAIN = false, MID = false;
    uchar* ws; float* out;
    DI void operator()(const f32x4 (&acc)[2][2][4][2], const Unit& u0, int wr, int wc, int fr, int fq) const {
        Unit u = u0; asm volatile("" : "+s"(u.pm), "+s"(u.pn));
        { int ln; asm volatile("v_mbcnt_lo_u32_b32 %0, -1, 0\n\tv_mbcnt_hi_u32_b32 %0, -1, %0" : "=v"(ln)); fr = ln & 15; fq = ln >> 4; }
        if (u.ks >= 0) {
            float* sl = (float*)(ws + WS_T1) + (size_t)u.ks * (768u * 4096u) + (size_t)((u.pm - 33) * BM + wr * 64 + fr) * 4096 + (u.pn - 28) * BM + wc * 32 + 8 * fq;
#pragma unroll
            for (int ai = 0; ai < 2; ++ai)
#pragma unroll
                for (int m = 0; m < 4; ++m)
#pragma unroll
                    for (int bj = 0; bj < 2; ++bj) { float* t = sl + (size_t)(ai * HALF + m * 16) * 4096 + bj * HALF; *(f32x4*)t = acc[ai][bj][m][0]; *(f32x4*)(t + 4) = acc[ai][bj][m][1]; }
            return;
        }
        const int grp = u.pn < 28 ? (u.pn >> 2) : 7;
        const int ld = (grp == 7) ? 4096 : 1024;
        const int cg0 = ((grp == 7) ? (u.pn - 28) : (u.pn & 3)) * BM + wc * 32 + 8 * fq;
        const size_t oboff = grp == 0 ? WS_QA : grp == 1 ? WS_LFA : grp == 2 ? WS_VA : grp == 3 ? WS_GA : grp == 4 ? WS_QB : grp == 5 ? WS_KB : grp == 6 ? WS_VB : WS_G;
        uchar* ob = ws + oboff;
        float* of = out + ((grp == 5) ? ((u.pm < 32) ? OUT_KP : OUT_KS - (size_t)MP * 1024) : ((u.pm < 32) ? OUT_VP : OUT_VS - (size_t)MP * 1024));
        float lb[2][8];
#pragma unroll
        for (int bj = 0; bj < 2; ++bj)
#pragma unroll
            for (int e = 0; e < 8; ++e) lb[bj][e] = 0.f;
        if (grp == 1) { const float* LB = (const float*)(ws + WS_LB);
#pragma unroll
            for (int bj = 0; bj < 2; ++bj) { const f32x4 a = *(const f32x4*)(LB + cg0 + bj * HALF), b = *(const f32x4*)(LB + cg0 + bj * HALF + 4);
                lb[bj][0] = a[0]; lb[bj][1] = a[1]; lb[bj][2] = a[2]; lb[bj][3] = a[3]; lb[bj][4] = b[0]; lb[bj][5] = b[1]; lb[bj][6] = b[2]; lb[bj][7] = b[3]; }
        }
#pragma unroll
        for (int ai = 0; ai < 2; ++ai)
#pragma unroll
            for (int m = 0; m < 4; ++m) {
                const size_t roff = (size_t)(u.pm * BM + wr * 64 + fr + ai * HALF + m * 16) * ld + cg0;
#pragma unroll
                for (int bj = 0; bj < 2; ++bj) {
                    float v[8];
#pragma unroll
                    for (int e = 0; e < 4; ++e) { v[e] = acc[ai][bj][m][0][e]; v[4 + e] = acc[ai][bj][m][1][e]; }
                    if (grp == 5 || grp == 6) { *(f32x4*)(of + roff + bj * HALF) = acc[ai][bj][m][0]; *(f32x4*)(of + roff + bj * HALF + 4) = acc[ai][bj][m][1]; }
                    if (grp == 0 || grp == 3) {
#pragma unroll
                        for (int e = 0; e < 8; ++e) v[e] = fsilu(v[e]);
                    } else if (grp == 1) {
#pragma unroll
                        for (int e = 0; e < 8; ++e) { const float s = fsigmoid(v[e]); v[e] = flog(lb[bj][e] + (1.0f - lb[bj][e]) * s); }
                    } else if (grp == 4) {
#pragma unroll
                        for (int e = 0; e < 8; ++e) v[e] *= QSCALE;
                    } else if (grp == 7) {
#pragma unroll
                        for (int e = 0; e < 8; ++e) v[e] = fsigmoid(v[e]);
                    }
                    if (grp == 1) { float* p = (float*)ob + roff + bj * HALF; *(f32x4*)p = (f32x4){v[0], v[1], v[2], v[3]}; *(f32x4*)(p + 4) = (f32x4){v[4], v[5], v[6], v[7]}; }
                    else { u32x4 w; w[0] = pk2(v[0], v[1]); w[1] = pk2(v[2], v[3]); w[2] = pk2(v[4], v[5]); w[3] = pk2(v[6], v[7]); *(u32x4*)((bf16*)ob + roff + bj * HALF) = w; }
                }
            }
    }
};

struct InProjOrder {
    StaticOrder a; int G, c;
    __device__ __forceinline__ void init(int G_, int c_) { a.init(33 * BM, N_INP, G_, c_); G = G_; c = c_; }
    __device__ __forceinline__ bool next(int i, Unit& u) const {
        const int L = i * G + c;
        if (L >= 1536 + 192) return false;
        int pm, pn; a.map(L < a.nwg ? L : 0, pm, pn);
        if (L < a.nwg) { u = Unit{pm, pn, 0, 0, -1}; return true; }
        if (L < 1536) { const int r = L - a.nwg; u = Unit{33 + r / 28, r % 28, 0, 0, -1}; return true; }
        const int s = L - 1536, ks = s & 3, tile = s >> 2; u = Unit{33 + tile / 16, 28 + tile % 16, 8 * ks, 8, ks}; return true;
    }
    __device__ __forceinline__ void a_ready(const Unit&) const {}
    __device__ __forceinline__ void done(const Unit&) const {}
};
template <int MODE> struct EpiMix {
    static constexpr bool PERM = true, AFTER_DRAIN = false, MID = false;
    const bf16* G; float* T1; bf16* O; int ld;
    DI void operator()(const f32x4 (&acc)[2][2][4][2], const Unit& u, int wr, int wc, int fr, int fq) const {
        const int row0 = u.pm * BM + wr * 64 + fr, col0 = u.pn * BM + wc * 32 + 8 * fq;
#pragma unroll
        for (int ai = 0; ai < 2; ++ai)
#pragma unroll
            for (int m = 0; m < 4; ++m) {
                const int r = row0 + ai * HALF + m * 16;
#pragma unroll
                for (int bj = 0; bj < 2; ++bj) {
                    const int c = col0 + bj * HALF;
                    float v[8];
#pragma unroll
                    for (int e = 0; e < 4; ++e) { v[e] = acc[ai][bj][m][0][e]; v[4 + e] = acc[ai][bj][m][1][e]; }
                    if (MODE == 0) {
                        float g[8]; unpack8(*(const u32x4*)(G + (size_t)r * 4096 + c), g);
                        float* t = T1 + (size_t)r * 2048 + c;
                        *(f32x4*)t = (f32x4){v[0] * g[0], v[1] * g[1], v[2] * g[2], v[3] * g[3]}; *(f32x4*)(t + 4) = (f32x4){v[4] * g[4], v[5] * g[5], v[6] * g[6], v[7] * g[7]};
                    } else if (MODE == 1) {
                        float g[8]; unpack8(*(const u32x4*)(G + (size_t)r * 4096 + 2048 + c), g);
                        const float* t = T1 + (size_t)r * 2048 + c; const f32x4 t0 = *(const f32x4*)t, t1 = *(const f32x4*)(t + 4);
                        u32x4 w; w[0] = pk2(t0[0] + v[0] * g[0], t0[1] + v[1] * g[1]); w[1] = pk2(t0[2] + v[2] * g[2], t0[3] + v[3] * g[3]);
                        w[2] = pk2(t1[0] + v[4] * g[4], t1[1] + v[5] * g[5]); w[3] = pk2(t1[2] + v[6] * g[6], t1[3] + v[7] * g[7]);
                        *(u32x4*)(O + (size_t)r * 2048 + c) = w;
                    } else {
#pragma unroll
                        for (int e = 0; e < 8; ++e) { const float t = fmaxf(v[e], 0.f); v[e] = t * t; }
                        u32x4 w; w[0] = pk2(v[0], v[1]); w[1] = pk2(v[2], v[3]); w[2] = pk2(v[4], v[5]); w[3] = pk2(v[6], v[7]);
                        *(u32x4*)(O + (size_t)r * ld + c) = w;
                    }
                }
            }
    }
};

struct EpiMerge {
    static constexpr bool PERM = true, AFTER_DRAIN = false, MID = true;
    const bf16* G; bf16* MG; float* slab;
    DI int tmid(const Unit& u) const { return (u.ks < 0) ? (W1K / BK) : -1; }
    DI void mid(f32x4 (&acc)[2][2][4][2], const Unit& u0, int wr, int wc, int fr, int fq) const {
        Unit u = u0; asm volatile("" : "+s"(u.pm), "+s"(u.pn));
        { int ln; asm volatile("v_mbcnt_lo_u32_b32 %0, -1, 0\n\tv_mbcnt_hi_u32_b32 %0, -1, %0" : "=v"(ln)); fr = ln & 15; fq = ln >> 4; }
        const int row0 = u.pm * BM + wr * 64 + fr, col0 = u.pn * BM + wc * 32 + 8 * fq;
#pragma unroll
        for (int ai = 0; ai < 2; ++ai)
#pragma unroll
            for (int m = 0; m < 4; ++m) { const bf16* gr = G + (size_t)(row0 + ai * HALF + m * 16) * 4096 + col0;
#pragma unroll
                for (int bj = 0; bj < 2; ++bj) { float ga[8], gb[8]; unpack8(*(const u32x4*)(gr + bj * HALF), ga); unpack8(*(const u32x4*)(gr + 2048 + bj * HALF), gb);
#pragma unroll
                    for (int e = 0; e < 4; ++e) { acc[ai][bj][m][0][e] *= ga[e] * frcp(fmaxf(gb[e], 1e-30f)); acc[ai][bj][m][1][e] *= ga[4 + e] * frcp(fmaxf(gb[4 + e], 1e-30f)); } } }
    }
    DI void operator()(const f32x4 (&acc)[2][2][4][2], const Unit& u0, int wr, int wc, int fr, int fq) const {
        Unit u = u0; asm volatile("" : "+s"(u.pm), "+s"(u.pn));
        { int ln; asm volatile("v_mbcnt_lo_u32_b32 %0, -1, 0\n\tv_mbcnt_hi_u32_b32 %0, -1, %0" : "=v"(ln)); fr = ln & 15; fq = ln >> 4; }
        const int row0 = u.pm * BM + wr * 64 + fr, col0 = u.pn * BM + wc * 32 + 8 * fq;
        const int goff = (u.ks >= 0 && u.ks < 4) ? 0 : 2048;
        float* sl = slab + (size_t)(u.ks < 0 ? 0 : u.ks) * ((size_t)MS * 2048) - (size_t)MP * 2048;
#pragma unroll
        for (int ai = 0; ai < 2; ++ai)
#pragma unroll
            for (int m = 0; m < 4; ++m) { const int r = row0 + ai * HALF + m * 16;
#pragma unroll
                for (int bj = 0; bj < 2; ++bj) { const int c = col0 + bj * HALF;
                    float g[8]; unpack8(*(const u32x4*)(G + (size_t)r * 4096 + goff + c), g);
                    float v[8];
#pragma unroll
                    for (int e = 0; e < 4; ++e) { v[e] = acc[ai][bj][m][0][e] * g[e]; v[4 + e] = acc[ai][bj][m][1][e] * g[4 + e]; }
                    if (u.ks < 0) { u32x4 w; w[0] = pk2(v[0], v[1]); w[1] = pk2(v[2], v[3]); w[2] = pk2(v[4], v[5]); w[3] = pk2(v[6], v[7]); *(u32x4*)(MG + (size_t)r * 2048 + c) = w; }
                    else { float* t = sl + (size_t)r * 2048 + c; *(f32x4*)t = (f32x4){v[0], v[1], v[2], v[3]}; *(f32x4*)(t + 4) = (f32x4){v[4], v[5], v[6], v[7]}; }
                } }
    }
};

struct SplitOrder {
    StaticOrder full; int nN, KT, KS;
    __device__ __forceinline__ void init(int N, int K, int G, int c, int KS_) { full.init(MP, N, G, c); nN = N / BM; KT = K / BK; KS = KS_; }
    __device__ __forceinline__ bool next(int i, Unit& u) const {
        const int L = i * full.G + full.c, nsp = (MS / BM) * nN * KS;
        if (L >= full.nwg + nsp) return false;
        const bool isfull = L < full.nwg;
        int pmf, pnf; full.map(isfull ? L : 0, pmf, pnf);
        const int s = isfull ? 0 : L - full.nwg, ks = s % KS, tile = s / KS, ntk = KT / KS;
        u = Unit{isfull ? pmf : MP / BM + tile / nN, isfull ? pnf : tile % nN, isfull ? 0 : ks * ntk, isfull ? 0 : ntk, isfull ? -1 : ks};
        return true;
    }
    __device__ __forceinline__ void a_ready(const Unit&) const {}
    __device__ __forceinline__ void done(const Unit&) const {}
};
struct EpiResid {
    static constexpr bool PERM = false, AFTER_DRAIN = false, MID = false;
    const float* base; float* out; float* slab;
    DI void operator()(const f32x4 (&acc)[2][2][4][2], const Unit& u, int wr, int wc, int fr, int fq) const {
        const int row0 = u.pm * BM + wr * 64 + fr, col0 = u.pn * BM + wc * 32 + 4 * fq;
        if (u.ks < 0) {
#pragma unroll
            for (int ai = 0; ai < 2; ++ai)
#pragma unroll
                for (int m = 0; m < 4; ++m) { const size_t off = (size_t)(row0 + ai * HALF + m * 16) * 2048 + col0;
#pragma unroll
                    for (int bj = 0; bj < 2; ++bj)
#pragma unroll
                        for (int n = 0; n < 2; ++n) { const f32x4 b = *(const f32x4*)(base + off + bj * HALF + n * 16); *(f32x4*)(out + off + bj * HALF + n * 16) = b + acc[ai][bj][m][n]; } }
        } else {
            float* sl = slab + (size_t)u.ks * ((size_t)MS * 2048) - (size_t)MP * 2048;
#pragma unroll
            for (int ai = 0; ai < 2; ++ai)
#pragma unroll
                for (int m = 0; m < 4; ++m) { const size_t off = (size_t)(row0 + ai * HALF + m * 16) * 2048 + col0;
#pragma unroll
                    for (int bj = 0; bj < 2; ++bj)
#pragma unroll
                        for (int n = 0; n < 2; ++n) *(f32x4*)(sl + off + bj * HALF + n * 16) = acc[ai][bj][m][n]; }
        }
    }
};
}
#define XB_TMO      128
#define XB_XCNT(j)  (256  + 64 * (j))
#define XB_XSUB(j)  (1280 + 64 * (j))
#define XB_XGEN(j)  (2304 + 64 * (j))
#define XB_TOP      3328
#define XB_TOPGEN   3392
#define XCD_BAR_WORDS 3456
#define XB_SPIN_CAP (1u << 18)

__device__ __forceinline__ unsigned xb_ld(unsigned* p)              { return __hip_atomic_load(p, __ATOMIC_RELAXED, __HIP_MEMORY_SCOPE_AGENT); }
__device__ __forceinline__ unsigned xb_add(unsigned* p, unsigned v) { return __hip_atomic_fetch_add(p, v, __ATOMIC_RELAXED, __HIP_MEMORY_SCOPE_AGENT); }
__device__ __forceinline__ unsigned xb_xcc_id() { return (unsigned)__builtin_amdgcn_s_getreg((3 << 11) | 20) & 0xFu; }
#define XB_SPIN(cond, bar) do { unsigned _sp = 0; while (cond) { __builtin_amdgcn_s_sleep(1); \
    if ((++_sp & 255u) == 0u) { if (xb_ld(&(bar)[XB_TMO])) break; if (_sp > XB_SPIN_CAP) { atomicAdd(&(bar)[XB_TMO], 1u); break; } } } } while (0)

struct XcdBarrier {
    unsigned* bar; unsigned x;
    volatile LAS unsigned* st;
};

__device__ __forceinline__ XcdBarrier xcd_barrier_post(unsigned* bar, volatile LAS unsigned* st) {
    XcdBarrier b; b.bar = bar; b.x = xb_xcc_id(); b.st = st;
    if (threadIdx.x == 0) (void)xb_add(&bar[XB_XCNT(b.x)], 1u);
    return b;
}
__device__ __forceinline__ void xcd_barrier_complete(unsigned* bar, unsigned x, unsigned& nloc, unsigned& nx) {
    const unsigned G = gridDim.x * gridDim.y * gridDim.z;
    unsigned sum, cnt, mine, sp = 0u;
    for (;;) {
        sum = 0u; cnt = 0u; mine = 0u;
#pragma unroll
        for (unsigned j = 0; j < 16; ++j) { const unsigned c = xb_ld(&bar[XB_XCNT(j)]); sum += c; cnt += (c > 0u) ? 1u : 0u; mine = (j == x) ? c : mine; }
        if (sum == G) break;
        __builtin_amdgcn_s_sleep(1);
        if ((++sp & 255u) == 0u) { if (xb_ld(&bar[XB_TMO])) break; if (sp > XB_SPIN_CAP) { atomicAdd(&bar[XB_TMO], 1u); break; } }
    }
    nloc = mine > 0u ? mine : 1u; nx = cnt > 0u ? cnt : 1u;
}

__device__ __forceinline__ void xcd_barrier(const XcdBarrier& b) {
    asm volatile("s_waitcnt vmcnt(0)" ::: "memory");
    __syncthreads();
    if (threadIdx.x == 0) {
        unsigned* bar = b.bar;
        __builtin_amdgcn_s_waitcnt(0);
        unsigned nloc = b.st[0], nx = b.st[1];
        if (nloc == 0u) { xcd_barrier_complete(bar, b.x, nloc, nx); b.st[0] = nloc; b.st[1] = nx; }
        const unsigned old = xb_add(&bar[XB_XSUB(b.x)], 1u);
        const unsigned gen = old / nloc;
        if (old + 1u == (gen + 1u) * nloc) {
            __builtin_amdgcn_fence(__ATOMIC_RELEASE, "agent");
            asm volatile("s_waitcnt vmcnt(0)" ::: "memory");
            const unsigned og = xb_add(&bar[XB_TOP], 1u);
            const unsigned tg = og / nx;
            if (og + 1u == (tg + 1u) * nx) xb_add(&bar[XB_TOPGEN], 1u);
            else XB_SPIN(xb_ld(&bar[XB_TOPGEN]) == tg, bar);
            __builtin_amdgcn_fence(__ATOMIC_ACQUIRE, "agent");
            xb_add(&bar[XB_XGEN(b.x)], 1u);
            asm volatile("s_waitcnt vmcnt(0)" ::: "memory");
        } else {
            XB_SPIN(xb_ld(&bar[XB_XGEN(b.x)]) == gen, bar);
            __builtin_amdgcn_fence(__ATOMIC_ACQUIRE, "agent");
            asm volatile("s_waitcnt vmcnt(0)" ::: "memory");
        }
    }
    __syncthreads();
}


struct Frame {
    LAS uchar* lds;
    int tid, lane, wave, G, bid;
    const float *x_p, *x_s, *ck, *cv, *clf, *st0, *norm1, *w_in, *b_fox, *lb_logits, *gnorm, *w_pa, *w_pb, *w_o, *norm2, *w1, *w2, *norm_f;
    float* out; uchar* ws;
};
template <class T> DI T* wsp(const Frame& F, size_t off) { return (T*)(F.ws + off); }
DI const float* xrow(const Frame& F, int row) { return row < MP ? F.x_p + (size_t)row * D_MODEL : F.x_s + (size_t)(row - MP) * D_MODEL; }

DI void p0_transpose_item(const float* W, int ldw, int ldt, bf16* WT, int nblk, int shift_from, int shift, LAS uchar* img, const FragAddr& fa, int item, int lane) {
    const int kb = item / nblk, nb = item % nblk, k0 = 64 * kb, n0 = 64 * nb, n0s = n0 + (n0 >= shift_from ? shift : 0);
    const float* src = W + (size_t)(k0 + (lane >> 4)) * ldw + n0s + 4 * (lane & 15);
    f32x4 r[16];
#pragma unroll
    for (int i = 0; i < 16; ++i) r[i] = *(const f32x4*)(src + (size_t)(4 * i) * ldw);
#pragma unroll
    for (int i = 0; i < 16; ++i) *(LAS u32x2*)(img + off_a((unsigned)(4 * i + (lane >> 4)), (unsigned)((lane & 15) >> 1)) + 8 * (lane & 1)) = (u32x2){pk2(r[i][0], r[i][1]), pk2(r[i][2], r[i][3])};
    bf16* dst = WT + (size_t)(n0 + (lane & 31)) * ldt + k0 + 8 * (lane >> 5);
#pragma unroll
    for (int c = 0; c < 2; ++c)
#pragma unroll
        for (int ks = 0; ks < 4; ++ks) { const bf16x8 v = frag_tr<false>(img, fa, 0, c, ks); *(bf16x8*)(dst + (size_t)(32 * c) * ldt + 16 * ks) = v; }
}
template <bool WITH_FL> DI void rms_row_bf16(const Frame& F, const float* xr, const float* g, bf16* orow, int row) {
    const f32x4* xv = (const f32x4*)xr + F.lane; const f32x4* gv = (const f32x4*)g + F.lane;
    f32x4 v[8]; float s = 0.f;
#pragma unroll
    for (int j = 0; j < 8; ++j) { v[j] = xv[64 * j]; s += (v[j][0] * v[j][0] + v[j][1] * v[j][1]) + (v[j][2] * v[j][2] + v[j][3] * v[j][3]); }
    const float rstd = 1.0f / sqrtf(wave_sum(s) * (1.0f / D_MODEL) + EPS);
    u32x2* o8 = (u32x2*)orow + F.lane;
#pragma unroll
    for (int j = 0; j < 8; ++j) { v[j] = v[j] * rstd * gv[64 * j]; o8[64 * j] = (u32x2){pk2(v[j][0], v[j][1]), pk2(v[j][2], v[j][3])}; }
    if (WITH_FL) {
        float mine = 0.f;
#pragma unroll
        for (int c = 0; c < 8; ++c) {
            float a = 0.f;
#pragma unroll
            for (int j = 0; j < 8; ++j) { const f32x4 w = *((const LAS f32x4*)(F.lds + RING_OFF) + c * 512 + 64 * j + F.lane); a += (v[j][0] * w[0] + v[j][1] * w[1]) + (v[j][2] * w[2] + v[j][3] * w[3]); }
            const float t = wave_sum(a); if (F.lane == c) mine = t;
            asm volatile("" ::: "memory");
        }
        if (F.lane < 8) {
            const float z = mine + F.b_fox[F.lane];
            const float ls = fminf(z, 0.f) - log1pf(expf(-fabsf(z)));
            wsp<float>(F, WS_LFB)[(size_t)row * 8 + F.lane] = ls;
            if (row < MP) F.out[OUT_LFP + (size_t)row * 8 + F.lane] = ls; else F.out[OUT_LFS + (size_t)(row - MP) * 8 + F.lane] = ls;
        }
    }
}
DI void p0_prologue(const Frame& F) {
    LAS uchar* img = F.lds + RING_OFF + F.wave * 16384;
    const FragAddr fa = make_frag_addr(F.lane);
    const int gw = F.bid * NWAVES + F.wave, NGW = F.G * NWAVES;
    { const int gid = F.bid * 512 + F.tid; if (gid < W1K) { const float a = F.lb_logits[gid], b = F.lb_logits[W1K + gid]; wsp<float>(F, WS_LB)[gid] = 1.0f / (1.0f + expf(b - a)); } }
    for (int idx = F.tid; idx < D_MODEL * 2; idx += NWAVES * 64) { const int k = idx >> 1, hf = idx & 1; const f32x4 w = *(const f32x4*)(F.w_in + (size_t)k * N_IN + COL_FL + 4 * hf);
        LAS float* t = (LAS float*)(F.lds + RING_OFF) + (4 * hf) * D_MODEL + k; t[0] = w[0]; t[D_MODEL] = w[1]; t[2 * D_MODEL] = w[2]; t[3 * D_MODEL] = w[3]; }
    __syncthreads();
    for (int m = gw; m < MROWS; m += NGW) rms_row_bf16<true>(F, xrow(F, m), F.norm1, wsp<bf16>(F, WS_H) + (size_t)m * D_MODEL, m);
    __syncthreads();
    constexpr int I_IN = (D_MODEL / 64) * (N_INP / 64), I_PA = (W1K / 64) * (D_MODEL / 64), I_O = (D_MODEL / 64) * (D_MODEL / 64), I_1 = (D_MODEL / 64) * (D_FF / 64), I_2 = (D_FF / 64) * (D_MODEL / 64);
    constexpr int NITEMS = I_IN + 2 * I_PA + I_O + I_1 + I_2;
    for (int it = gw; it < NITEMS; it += NGW) {
        int r = it;
        if (r < I_IN) { p0_transpose_item(F.w_in, N_IN, D_MODEL, wsp<bf16>(F, WS_WIN), N_INP / 64, COL_FL, 8, img, fa, r, F.lane); continue; } r -= I_IN;
        if (r < I_PA) { p0_transpose_item(F.w_pa, D_MODEL, D_MODEL, wsp<bf16>(F, WS_WP), D_MODEL / 64, 1 << 30, 0, img, fa, r, F.lane); continue; } r -= I_PA;
        if (r < I_PA) { p0_transpose_item(F.w_pb, D_MODEL, D_MODEL, wsp<bf16>(F, WS_WP) + W1K, D_MODEL / 64, 1 << 30, 0, img, fa, r, F.lane); continue; } r -= I_PA;
        if (r < I_O) { p0_transpose_item(F.w_o, D_MODEL, D_MODEL, wsp<bf16>(F, WS_WO), D_MODEL / 64, 1 << 30, 0, img, fa, r, F.lane); continue; } r -= I_O;
        if (r < I_1) { p0_transpose_item(F.w1, D_FF, D_MODEL, wsp<bf16>(F, WS_W1), D_FF / 64, 1 << 30, 0, img, fa, r, F.lane); continue; } r -= I_1;
        p0_transpose_item(F.w2, D_MODEL, D_FF, wsp<bf16>(F, WS_W2), D_MODEL / 64, 1 << 30, 0, img, fa, r, F.lane);
    }
}

DI void scan_rows(const float* src, int n, float (&carry)[8], float* dst, size_t dstride, int j0, int lane) {
    for (int i0 = 0; i0 < n; i0 += 64) {
        const int j = i0 + lane; const bool ok = j < n;
        float v[8];
        { f32x4 a = {0.f, 0.f, 0.f, 0.f}, b = {0.f, 0.f, 0.f, 0.f}; if (ok) { a = *(const f32x4*)(src + (size_t)j * 8); b = *(const f32x4*)(src + (size_t)j * 8 + 4); }
          v[0] = a[0]; v[1] = a[1]; v[2] = a[2]; v[3] = a[3]; v[4] = b[0]; v[5] = b[1]; v[6] = b[2]; v[7] = b[3]; }
#pragma unroll
        for (int h = 0; h < 8; ++h) {
#pragma unroll
            for (int o = 1; o < 64; o <<= 1) { const float t = __shfl_up(v[h], o); if (lane >= o) v[h] += t; }
            v[h] += carry[h];
            carry[h] = __shfl(v[h], 63);
            if (ok) dst[(size_t)h * dstride + j0 + j] = v[h] * LOG2E;
        }
    }
}
DI void sum_rows(const float* src, int n, float (&tot)[8], int lane) {
    float a[8];
#pragma unroll
    for (int h = 0; h < 8; ++h) a[h] = 0.f;
#pragma unroll 1
    for (int j0 = 0; j0 < n; j0 += 512) {
        f32x4 x[8], y[8];
#pragma unroll
        for (int i = 0; i < 8; ++i) { const float* p = src + (size_t)(j0 + 64 * i + lane) * 8; x[i] = *(const f32x4*)p; y[i] = *(const f32x4*)(p + 4); }
#pragma unroll
        for (int i = 0; i < 8; ++i) { a[0] += x[i][0]; a[1] += x[i][1]; a[2] += x[i][2]; a[3] += x[i][3]; a[4] += y[i][0]; a[5] += y[i][1]; a[6] += y[i][2]; a[7] += y[i][3]; }
    }
#pragma unroll
    for (int h = 0; h < 8; ++h) tot[h] = wave_sum(a[h]);
}
DI void scan_seg512(const float* src, float (&carry)[8], float* dst, size_t dstride, int j0, int lane) {
    f32x4 a[8], b[8];
#pragma unroll
    for (int r = 0; r < 8; ++r) { const float* p = src + (size_t)(8 * lane + r) * 8; a[r] = *(const f32x4*)p; b[r] = *(const f32x4*)(p + 4); }
#pragma unroll
    for (int r = 1; r < 8; ++r) { a[r] += a[r - 1]; b[r] += b[r - 1]; }
    float off[8];
#pragma unroll
    for (int h = 0; h < 8; ++h) {
        const float own = (h < 4) ? a[7][h & 3] : b[7][h & 3];
        float inc = own;
#pragma unroll
        for (int o = 1; o < 64; o <<= 1) { const float t = __shfl_up(inc, o); if (lane >= o) inc += t; }
        off[h] = carry[h] + (inc - own);
        carry[h] += __shfl(inc, 63);
    }
#pragma unroll
    for (int h = 0; h < 8; ++h) {
        float* d = dst + (size_t)h * dstride + j0 + 8 * lane;
        f32x4 lo, hi;
#pragma unroll
        for (int r = 0; r < 4; ++r) { lo[r] = (((h < 4) ? a[r][h & 3] : b[r][h & 3]) + off[h]) * LOG2E; hi[r] = (((h < 4) ? a[4 + r][h & 3] : b[4 + r][h & 3]) + off[h]) * LOG2E; }
        *(f32x4*)d = lo; *(f32x4*)(d + 4) = hi;
    }
}
DI void scan_task(const Frame& F, int task) {
    const int sq = task >> 3, seg = task & 7;
    float carry[8];
    const float* lfb = wsp<float>(F, WS_LFB);
    if (sq < NB_P) { const float* src = lfb + (size_t)sq * SEQ * 8;
        sum_rows(src, seg * 512, carry, F.lane);
        scan_seg512(src + (size_t)seg * 512 * 8, carry, wsp<float>(F, WS_C2P) + (size_t)sq * 8 * SEQ, SEQ, seg * 512, F.lane); }
    else { const int b = sq - NB_P; float* dst = wsp<float>(F, WS_C2S) + (size_t)b * 8 * SKV_S; const float* src = F.clf + (size_t)b * PAST * 8;
        sum_rows(src, seg * 512, carry, F.lane);
        scan_seg512(src + (size_t)seg * 512 * 8, carry, dst, SKV_S, seg * 512, F.lane);
        if (seg == 7) scan_rows(lfb + (size_t)(MP + b * T_S) * 8, T_S, carry, dst, SKV_S, PAST, F.lane); }
}
constexpr int N_SCAN_TASKS = (NB_P + NB_S) * 8;
DI void unpack8x(const u32x4 w, float (&f)[8]) { f[0] = bf_lo(w[0]); f[1] = bf_hi(w[0]); f[2] = bf_lo(w[1]); f[3] = bf_hi(w[1]); f[4] = bf_lo(w[2]); f[5] = bf_hi(w[2]); f[6] = bf_lo(w[3]); f[7] = bf_hi(w[3]); }
DI void p_attn_stats(const Frame& F) {
    const int lane = F.lane;
    float* qn = wsp<float>(F, WS_QN); float* md = qn + 16 * SEQ; unsigned* kmax = (unsigned*)(F.ws + WS_CTL) + CW_KMAX;
    LAS float* red = (LAS float*)(F.lds + SCR_OFF);
    for (int r0 = F.bid * 32; r0 < MP; r0 += F.G * 32) {
        float kmx = 0.f;
#pragma unroll
        for (int rr = 0; rr < 4; ++rr) {
            const int row = r0 + 4 * F.wave + rr;
            const size_t o = (size_t)row * W1K + 16 * lane;
            float qv[16], kv[16];
            { float t[8]; unpack8x(*(const u32x4*)(wsp<bf16>(F, WS_QB) + o), t);
#pragma unroll
              for (int e = 0; e < 8; ++e) qv[e] = t[e];
              unpack8x(*(const u32x4*)(wsp<bf16>(F, WS_QB) + o + 8), t);
#pragma unroll
              for (int e = 0; e < 8; ++e) qv[8 + e] = t[e];
              unpack8x(*(const u32x4*)(wsp<bf16>(F, WS_KB) + o), t);
#pragma unroll
              for (int e = 0; e < 8; ++e) kv[e] = t[e];
              unpack8x(*(const u32x4*)(wsp<bf16>(F, WS_KB) + o + 8), t);
#pragma unroll
              for (int e = 0; e < 8; ++e) kv[8 + e] = t[e]; }
            float qq = 0.f, kk = 0.f, qk = 0.f;
#pragma unroll
            for (int e = 0; e < 16; ++e) { qq += qv[e] * qv[e]; kk += kv[e] * kv[e]; qk += qv[e] * kv[e]; }
#pragma unroll
            for (int o2 = 1; o2 < 8; o2 <<= 1) { qq += __shfl_xor(qq, o2); kk += __shfl_xor(kk, o2); qk += __shfl_xor(qk, o2); }
            kmx = fmaxf(kmx, sqrtf(kk));
            if ((lane & 7) == 0) { const int head = lane >> 3, b = row >> 12, t = row & (SEQ - 1), bh = b * NH + head;
                qn[(size_t)bh * SEQ + t] = sqrtf(qq); md[(size_t)bh * SEQ + t] = qk; }
        }
        if ((lane & 7) == 0) red[F.wave * 8 + (lane >> 3)] = kmx;
        __syncthreads();
        if (F.tid < 8) { float v = red[F.tid];
#pragma unroll
            for (int w = 1; w < 8; ++w) v = fmaxf(v, red[w * 8 + F.tid]);
            const int b = r0 >> 12, t = r0 & (SEQ - 1);
            atomicMax(kmax + (b * NH + F.tid) * 32 + (t >> 7), __float_as_uint(v)); }
        __syncthreads();
    }
}
DI void p_combine_gate(const Frame& F) {
    const int gid = F.bid * 512 + F.tid, NT = F.G * 512;
    const float* sl = wsp<float>(F, WS_T1); bf16* G = wsp<bf16>(F, WS_G) + (size_t)(33 * 256) * 4096;
    for (int i = gid; i < 768 * 4096 / 8; i += NT) {
        f32x4 a = *(const f32x4*)(sl + (size_t)i * 8), b = *(const f32x4*)(sl + (size_t)i * 8 + 4);
#pragma unroll
        for (int ks = 1; ks < 4; ++ks) { a += *(const f32x4*)(sl + (size_t)ks * (768u * 4096u) + (size_t)i * 8); b += *(const f32x4*)(sl + (size_t)ks * (768u * 4096u) + (size_t)i * 8 + 4); }
        u32x4 w; w[0] = pk2(fsigmoid(a[0]), fsigmoid(a[1])); w[1] = pk2(fsigmoid(a[2]), fsigmoid(a[3])); w[2] = pk2(fsigmoid(b[0]), fsigmoid(b[1])); w[3] = pk2(fsigmoid(b[2]), fsigmoid(b[3]));
        *(u32x4*)(G + (size_t)i * 8) = w;
    }
}
DI void unit_rc(int u, int& row0, int& head) { if (u < NU_P) { const int bh = u >> 7, c = u & 127; row0 = (bh >> 3) * SEQ + c * CHK; head = bh & 7; } else { const int su = u - NU_P; row0 = MP + (su >> 3) * T_S; head = su & 7; } }
constexpr int HG_QT = 0, HG_KT = 8192, HG_KP = 16384, HG_V = 24576, HG_SP = 32768;
struct HgPre { f32x4 lf[4]; u32x2 q[4]; u32x4 v[2]; };
DI void hgrn_load(const Frame& F, int u, int tl, HgPre& P) {
    int row0, head; unit_rc(u, row0, head);
    const int cg = tl & 31, rg = tl >> 5;
    const size_t o = (size_t)(row0 + 4 * rg) * W1K + head * DH + 4 * cg;
#pragma unroll
    for (int r = 0; r < 4; ++r) { P.lf[r] = *(const f32x4*)(wsp<float>(F, WS_LFA) + o + (size_t)r * W1K); P.q[r] = *(const u32x2*)(wsp<bf16>(F, WS_QA) + o + (size_t)r * W1K); }
#pragma unroll
    for (int i = 0; i < 2; ++i) { const int idx = tl + 256 * i, row = idx >> 4, ch = idx & 15; P.v[i] = *(const u32x4*)(wsp<bf16>(F, WS_VA) + (size_t)(row0 + row) * W1K + head * DH + ch * 8); }
}
DI void hgrn_stage1(HgPre& P, int tl, LAS float* tot) {
    P.lf[1] += P.lf[0]; P.lf[2] += P.lf[1]; P.lf[3] += P.lf[2];
    *(LAS f32x4*)(tot + (tl >> 5) * DH + 4 * (tl & 31)) = P.lf[3];
}
template <bool WRITE_DEC> DI void hgrn_stage2(const Frame& F, int u, int tl, const HgPre& P, LAS uchar* base, const LAS float* tot) {
    const int cg = tl & 31, rg = tl >> 5;
    f32x4 pre = {0.f, 0.f, 0.f, 0.f}, bend = {0.f, 0.f, 0.f, 0.f};
#pragma unroll
    for (int g = 0; g < 8; ++g) { const f32x4 t = *(const LAS f32x4*)(tot + g * DH + 4 * cg); bend += t; if (g < rg) pre += t; }
#pragma unroll
    for (int r = 0; r < 4; ++r) {
        const f32x4 b = pre + P.lf[r];
        const f32x4 lf = (r == 0) ? P.lf[0] : (f32x4)(P.lf[r] - P.lf[r > 0 ? r - 1 : 0]);
        const float q0 = bf_lo(P.q[r][0]), q1 = bf_hi(P.q[r][0]), q2 = bf_lo(P.q[r][1]), q3 = bf_hi(P.q[r][1]);
        float qt[4], kt[4], kp[4];
        const float qq[4] = {q0, q1, q2, q3};
#pragma unroll
        for (int e = 0; e < 4; ++e) { const float k = 1.0f - fexp(lf[e]); qt[e] = qq[e] * fexp(b[e]); kt[e] = k * fexp(-b[e]); kp[e] = k * fexp(bend[e] - b[e]); }
        const unsigned a = off_a((unsigned)(4 * rg + r), (unsigned)(cg >> 1)) + 8u * (cg & 1);
        *(LAS u32x2*)(base + HG_QT + a) = (u32x2){pk2(qt[0], qt[1]), pk2(qt[2], qt[3])};
        *(LAS u32x2*)(base + HG_KT + a) = (u32x2){pk2(kt[0], kt[1]), pk2(kt[2], kt[3])};
        *(LAS u32x2*)(base + HG_KP + a) = (u32x2){pk2(kp[0], kp[1]), pk2(kp[2], kp[3])};
    }
    if (WRITE_DEC && rg == 0) *(f32x4*)(wsp<float>(F, WS_DEC) + (size_t)u * DH + 4 * cg) = (f32x4){fexp(bend[0]), fexp(bend[1]), fexp(bend[2]), fexp(bend[3])};
#pragma unroll
    for (int i = 0; i < 2; ++i) { const int idx = tl + 256 * i, row = idx >> 4, ch = idx & 15; *(LAS u32x4*)(base + HG_V + off_a((unsigned)row, (unsigned)ch)) = P.v[i]; }
}
DI void p3_hgrn_local(const Frame& F) {
    const int hw = F.wave >> 2, wl = F.wave & 3, tl = F.tid & 255, lane = F.lane, h = lane >> 5;
    LAS uchar* base = F.lds + RING_OFF + hw * 65536;
    LAS float* tot = (LAS float*)(F.lds + QIMG_OFF) + hw * (8 * DH);
    const FragAddr fa = make_frag_addr(lane);
    HgPre P;
    int it = F.bid;
    if (it < NU / 2) hgrn_load(F, 2 * it + hw, tl, P);
    for (; it < NU / 2; it += F.G) {
        const int u = 2 * it + hw;
        hgrn_stage1(P, tl, tot);
        __syncthreads();
        hgrn_stage2<true>(F, u, tl, P, base, tot);
        if (it + F.G < NU / 2) hgrn_load(F, 2 * (it + F.G) + hw, tl, P);
        __syncthreads();
        float* ds = wsp<float>(F, WS_DS) + (size_t)u * (DH * DH);
        const int dt = wl;
        const bf16x8 a0 = frag_tr<false>(base + HG_KP, fa, 0, dt, 0), a1 = frag_tr<false>(base + HG_KP, fa, 0, dt, 1);
#pragma unroll
        for (int et = 0; et < 4; ++et) {
            f32x16 acc;
#pragma unroll
            for (int i = 0; i < 16; ++i) acc[i] = 0.f;
            acc = MFMA32(a0, frag_tr<false>(base + HG_V, fa, 0, et, 0), acc);
            acc = MFMA32(a1, frag_tr<false>(base + HG_V, fa, 0, et, 1), acc);
#pragma unroll
            for (int i = 0; i < 16; ++i) { const int d = 32 * dt + (i & 3) + 8 * (i >> 2) + 4 * h; ds[(size_t)d * DH + 32 * et + (lane & 31)] = acc[i]; }
        }
        __syncthreads();
    }
}
DI void p4_hgrn_scan(const Frame& F) {
    const int gid = F.bid * 512 + F.tid, NT = F.G * 512;
    const float* DSb = wsp<float>(F, WS_DS); const float* DEC = wsp<float>(F, WS_DEC); bf16* SP = wsp<bf16>(F, WS_SP);
    for (int ch = gid; ch < NB_P * NH * DH * (DH / 2); ch += NT) {
        const int bh = ch >> 13, d = (ch >> 6) & 127, e = (ch & 63) * 2;
        float s0 = 0.f, s1 = 0.f;
        const size_t eo = (size_t)d * DH + e;
#pragma unroll 1
        for (int c0 = 0; c0 < NCH; c0 += 16) {
            f32x2 dv[16]; float dc[16];
#pragma unroll
            for (int j = 0; j < 16; ++j) { const int u = bh * NCH + c0 + j; dv[j] = *(const f32x2*)(DSb + (size_t)u * (DH * DH) + eo); dc[j] = DEC[(size_t)u * DH + d]; }
#pragma unroll
            for (int j = 0; j < 16; ++j) { const int u = bh * NCH + c0 + j;
                *(unsigned*)(SP + (size_t)u * (DH * DH) + eo) = pk2(s0, s1);
                s0 = s0 * dc[j] + dv[j][0]; s1 = s1 * dc[j] + dv[j][1]; }
        }
        *(f32x2*)(F.out + OUT_SP + (size_t)bh * (DH * DH) + eo) = (f32x2){s0, s1};
    }
    for (int i = gid; i < NU_S * DH * DH / 4; i += NT) {
        const int su = i >> 12, r = i & 4095, d = r >> 5;
        const int u = NU_P + su;
        const f32x4 s0 = *(const f32x4*)(F.st0 + (size_t)i * 4), dv = *(const f32x4*)(DSb + (size_t)u * (DH * DH) + (size_t)r * 4); const float dc = DEC[(size_t)u * DH + d];
        *(f32x4*)(F.out + OUT_SS + (size_t)i * 4) = s0 * dc + dv;
    }
}
DI void p5_hgrn_out(const Frame& F) {
    const int hw = F.wave >> 2, wl = F.wave & 3, tl = F.tid & 255, lane = F.lane, h = lane >> 5, t = lane & 31;
    LAS uchar* base = F.lds + RING_OFF + hw * 65536;
    LAS float* red = (LAS float*)(F.lds + SCR_OFF) + hw * 128;
    LAS float* tot = (LAS float*)(F.lds + QIMG_OFF) + hw * (8 * DH);
    const FragAddr fa = make_frag_addr(lane);
    HgPre P; u32x4 spr[8];
#define HG_LOAD_SP(uu) do { if ((uu) < NU_P) { const bf16* sp_ = wsp<bf16>(F, WS_SP) + (size_t)(uu) * (DH * DH); _Pragma("unroll") for (int i = 0; i < 8; ++i) { const int idx = tl + 256 * i; spr[i] = *(const u32x4*)(sp_ + (size_t)(idx >> 4) * DH + (idx & 15) * 8); } } } while (0)
    int it = F.bid;
    if (it < NU / 2) { hgrn_load(F, 2 * it + hw, tl, P); HG_LOAD_SP(2 * it + hw); }
    for (; it < NU / 2; it += F.G) {
        const int u = 2 * it + hw;
        int row0, head; unit_rc(u, row0, head);
        hgrn_stage1(P, tl, tot);
        __syncthreads();
        hgrn_stage2<false>(F, u, tl, P, base, tot);
        if (u < NU_P) {
#pragma unroll
            for (int i = 0; i < 8; ++i) { const int idx = tl + 256 * i, row = idx >> 4, ch = idx & 15; *(LAS u32x4*)(base + HG_SP + off_a((unsigned)row, (unsigned)ch)) = spr[i]; }
        } else {
            const float* sp = F.st0 + (size_t)(u - NU_P) * (DH * DH);
#pragma unroll
            for (int i = 0; i < 16; ++i) { const int idx = tl + 256 * i, row = idx >> 5, c4 = idx & 31; const f32x4 v = *(const f32x4*)(sp + (size_t)row * DH + c4 * 4);
                *(LAS u32x2*)(base + HG_SP + off_a((unsigned)row, (unsigned)(c4 >> 1)) + 8 * (c4 & 1)) = (u32x2){pk2(v[0], v[1]), pk2(v[2], v[3])}; }
        }
        if (it + F.G < NU / 2) { hgrn_load(F, 2 * (it + F.G) + hw, tl, P); HG_LOAD_SP(2 * (it + F.G) + hw); }
        __syncthreads();
        const int et = wl;
        const bf16* ga = wsp<bf16>(F, WS_GA) + (size_t)(row0 + t) * W1K + head * DH; bf16* oa = wsp<bf16>(F, WS_OAB) + (size_t)(row0 + t) * 2048 + head * DH;
        u32x2 gw2[4];
#pragma unroll
        for (int g = 0; g < 4; ++g) gw2[g] = *(const u32x2*)(ga + 32 * et + 8 * g + 4 * h);
        bf16x8 qf[8];
#pragma unroll
        for (int ks = 0; ks < 8; ++ks) qf[ks] = frag_row(base + HG_QT, fa, 0, ks);
        f32x16 at, o;
#pragma unroll
        for (int i = 0; i < 16; ++i) { at[i] = 0.f; o[i] = 0.f; }
#pragma unroll
        for (int ks = 0; ks < 8; ++ks) at = MFMA32(frag_row(base + HG_KT, fa, 0, ks), qf[ks], at);
#pragma unroll
        for (int i = 0; i < 16; ++i) { const int s = (i & 3) + 8 * (i >> 2) + 4 * h; at[i] = (s <= t) ? at[i] : 0.f; }
#pragma unroll
        for (int ks = 0; ks < 8; ++ks) o = MFMA32(frag_tr<false>(base + HG_SP, fa, 0, et, ks), qf[ks], o);
        o = MFMA32(frag_tr<true>(base + HG_V, fa, 0, et, 0), pack_acc(at, 0), o);
        o = MFMA32(frag_tr<true>(base + HG_V, fa, 0, et, 1), pack_acc(at, 1), o);
        float ss = 0.f;
#pragma unroll
        for (int i = 0; i < 16; ++i) ss += o[i] * o[i];
        ss += __shfl_xor(ss, 32);
        if (h == 0) red[wl * 32 + t] = ss;
        __syncthreads();
        const float totss = (red[t] + red[32 + t]) + (red[64 + t] + red[96 + t]);
        const float rstd = 1.0f / sqrtf(totss * (1.0f / DH) + EPS);
#pragma unroll
        for (int g = 0; g < 4; ++g) {
            const int e0 = 32 * et + 8 * g + 4 * h;
            const f32x4 gn = *(const f32x4*)(F.gnorm + e0);
            const float v0 = o[4 * g + 0] * rstd * gn[0] * bf_lo(gw2[g][0]), v1 = o[4 * g + 1] * rstd * gn[1] * bf_hi(gw2[g][0]), v2 = o[4 * g + 2] * rstd * gn[2] * bf_lo(gw2[g][1]), v3 = o[4 * g + 3] * rstd * gn[3] * bf_hi(gw2[g][1]);
            *(u32x2*)(oa + e0) = (u32x2){pk2(v0, v1), pk2(v2, v3)};
        }
        __syncthreads();
    }
#undef HG_LOAD_SP
}

template <bool QLDS> DI bool flash_qk(const bool MASK, const bf16x8 (&qf)[8], LAS uchar* qimg, LAS uchar* kimg, int R0, const f32x4 (&ckv)[4], float cq2, int kabs0, int qabs, float& m, float& l, f32x16 (&o)[4], bf16x8& pf0, bf16x8& pf1, int lane, const FragAddr& fa) {
    const int h = lane >> 5;
    f32x16 s;
#pragma unroll
    for (int i = 0; i < 16; ++i) s[i] = 0.f;
#pragma unroll
    for (int ks = 0; ks < 8; ++ks) s = MFMA32(frag_row(kimg, fa, R0, ks), QLDS ? frag_row(qimg, fa, 0, ks) : qf[ks], s);
    float mx = -INFINITY;
#pragma unroll
    for (int g = 0; g < 4; ++g) {
        const f32x4 ck = ckv[g];
#pragma unroll
        for (int e = 0; e < 4; ++e) {
            float v = s[4 * g + e] + (cq2 - ck[e]);
            if (MASK) { const int key = kabs0 + 8 * g + 4 * h + e; v = (key <= qabs) ? v : -INFINITY; }
            s[4 * g + e] = v; mx = fmaxf(mx, v);
        }
    }
    mx = fmaxf(mx, __shfl_xor(mx, 32));
    if (__all(mx < m - 150.f)) return false;
    if (__any(mx > m)) {
        const float mn = fmaxf(m, mx), alpha = fexp2(m - mn);
        m = mn; l *= alpha;
#pragma unroll
        for (int dt = 0; dt < 4; ++dt) o[dt] = o[dt] * alpha;
    }
    float ps = 0.f;
#pragma unroll
    for (int i = 0; i < 16; ++i) { const float p = fexp2(s[i] - m); s[i] = p; ps += p; }
    l += ps;
    pf0 = pack_acc(s, 0); pf1 = pack_acc(s, 1);
    return true;
}
DI void flash_pv(LAS uchar* vimg, int R0, const bf16x8& pf0, const bf16x8& pf1, f32x16 (&o)[4], const FragAddr& fa) {
#pragma unroll
    for (int dt = 0; dt < 4; ++dt) o[dt] = MFMA32(frag_tr<true>(vimg, fa, R0, dt, 0), pf0, o[dt]);
#pragma unroll
    for (int dt = 0; dt < 4; ++dt) o[dt] = MFMA32(frag_tr<true>(vimg, fa, R0, dt, 1), pf1, o[dt]);
}

DI void attn_prompt_unit(const Frame& F, int bh, int qb) {
    const int lane = F.lane, w = F.wave, wq = w & 3, wk = w >> 2, h = lane >> 5, c = lane & 31, tid = F.tid;
    const int b = bh >> 3, head = bh & 7;
    const FragAddr fa = make_frag_addr(lane);
    const bf16* Qg = wsp<bf16>(F, WS_QB) + (size_t)b * SEQ * W1K + head * DH;
    const bf16* Kg = wsp<bf16>(F, WS_KB) + (size_t)b * SEQ * W1K + head * DH;
    const bf16* Vg = wsp<bf16>(F, WS_VB) + (size_t)b * SEQ * W1K + head * DH;
    const float* c2 = wsp<float>(F, WS_C2P) + (size_t)bh * SEQ;
    const int q0 = qb * 128, qabs = q0 + 32 * wq + c, nit = qb + 1;
    int it_lo;
    { const float* qn = wsp<float>(F, WS_QN) + (size_t)bh * SEQ; const float* mdg = qn + 16 * SEQ;
      float QN = fmaxf(qn[q0 + lane], qn[q0 + 64 + lane]), MD = fminf(mdg[q0 + lane], mdg[q0 + 64 + lane]);
#pragma unroll
      for (int o2 = 1; o2 < 64; o2 <<= 1) { QN = fmaxf(QN, __shfl_xor(QN, o2)); MD = fminf(MD, __shfl_xor(MD, o2)); }
      const int blk = lane < nit ? lane : 0;
      const float kmx = __uint_as_float(((const unsigned*)(F.ws + WS_CTL) + CW_KMAX)[bh * 32 + blk]);
      const float bound = QN * kmx * 1.001f + c2[q0] - c2[blk * 128 + 127];
      const bool active = (lane < nit) && !(bound < MD - 160.f);
      const unsigned long long bal = __ballot(active);
      it_lo = bal ? (int)__builtin_ctzll(bal) : nit - 1;
      if (it_lo > nit - 1) it_lo = nit - 1; }
    bf16x8 qf[8];
#pragma unroll
    for (int ks = 0; ks < 8; ++ks) qf[ks] = *(const bf16x8*)(Qg + (size_t)qabs * W1K + 16 * ks + 8 * h);
    const float cq2 = c2[qabs];
    float m = -1e30f, l = 0.f; f32x16 o[4];
#pragma unroll
    for (int dt = 0; dt < 4; ++dt)
#pragma unroll
        for (int i = 0; i < 16; ++i) o[dt][i] = 0.f;
    u32x4 kr[4], vr[4]; f32x4 cr = {0.f, 0.f, 0.f, 0.f};
#define AP_LOAD(itx) do { _Pragma("unroll") for (int i = 0; i < 4; ++i) { const int idx = tid + 512 * i, key = idx >> 4, ch = idx & 15; const size_t go = (size_t)((itx) * 128 + key) * W1K + ch * 8; \
        kr[i] = *(const u32x4*)(Kg + go); vr[i] = *(const u32x4*)(Vg + go); } if (tid < 32) cr = *(const f32x4*)(c2 + (itx) * 128 + tid * 4); } while (0)
#define AP_WRITE(sx) do { LAS uchar* sb_ = F.lds + RING_OFF + (sx) * 65536; _Pragma("unroll") for (int i = 0; i < 4; ++i) { const int idx = tid + 512 * i, key = idx >> 4, ch = idx & 15; \
        const unsigned a = (unsigned)(key >> 6) * 16384u + off_a((unsigned)(key & 63), (unsigned)ch); *(LAS u32x4*)(sb_ + a) = kr[i]; *(LAS u32x4*)(sb_ + 32768 + a) = vr[i]; } if (tid < 32) *((LAS f32x4*)(F.lds + SCR_OFF + 1024) + (sx) * 32 + tid) = cr; } while (0)
    AP_LOAD(nit - 1); AP_WRITE((nit - 1) & 1);
    __syncthreads();
    for (int it = nit - 1; it >= it_lo; --it) {
        const bool more = it > it_lo;
        if (more) AP_LOAD(it - 1);
        LAS uchar* sb = F.lds + RING_OFF + (it & 1) * 65536;
        LAS uchar* kimg = sb + wk * 16384; LAS uchar* vimg = sb + 32768 + wk * 16384;
        const int kabs0 = it * 128 + wk * 64;
        bf16x8 pf0, pf1;
        const bool diag = (it == nit - 1);
#pragma unroll 1
        for (int R0 = 32; R0 >= 0; R0 -= 32) {
            f32x4 ckv[4];
            { const LAS float* cl = (const LAS float*)(F.lds + SCR_OFF + 1024) + (it & 1) * 128 + wk * 64 + R0 + 4 * h;
#pragma unroll
              for (int g = 0; g < 4; ++g) ckv[g] = *(const LAS f32x4*)(cl + 8 * g); }
            if (flash_qk<false>(diag, qf, nullptr, kimg, R0, ckv, cq2, kabs0 + R0, qabs, m, l, o, pf0, pf1, lane, fa)) flash_pv(vimg, R0, pf0, pf1, o, fa);
        }
        if (more) AP_WRITE((it - 1) & 1);
        __syncthreads();
    }
#undef AP_LOAD
#undef AP_WRITE
    LAS f32x4* xb = (LAS f32x4*)(F.lds + RING_OFF) + wq * (17 * 64);
    if (wk == 1) {
#pragma unroll
        for (int dt = 0; dt < 4; ++dt)
#pragma unroll
            for (int g = 0; g < 4; ++g) xb[(dt * 4 + g) * 64 + lane] = (f32x4){o[dt][4 * g], o[dt][4 * g + 1], o[dt][4 * g + 2], o[dt][4 * g + 3]};
        xb[16 * 64 + lane] = (f32x4){m, l, 0.f, 0.f};
    }
    __syncthreads();
    if (wk == 0) {
        const f32x4 ml = xb[16 * 64 + lane];
        const float mn = fmaxf(m, ml[0]), a0 = fexp2(m - mn), a1 = fexp2(ml[0] - mn);
        float lt = l * a0 + ml[1] * a1;
        lt += __shfl_xor(lt, 32);
        const float inv = 1.0f / lt;
        bf16* og = wsp<bf16>(F, WS_OAB) + (size_t)(b * SEQ + qabs) * 2048 + W1K + head * DH;
#pragma unroll
        for (int dt = 0; dt < 4; ++dt)
#pragma unroll
            for (int g = 0; g < 4; ++g) {
                const f32x4 p = xb[(dt * 4 + g) * 64 + lane];
                const float v0 = (o[dt][4 * g] * a0 + p[0] * a1) * inv, v1 = (o[dt][4 * g + 1] * a0 + p[1] * a1) * inv, v2 = (o[dt][4 * g + 2] * a0 + p[2] * a1) * inv, v3 = (o[dt][4 * g + 3] * a0 + p[3] * a1) * inv;
                *(u32x2*)(og + 32 * dt + 8 * g + 4 * h) = (u32x2){pk2(v0, v1), pk2(v2, v3)};
            }
    }
    __syncthreads();
}
DI void p6_attn_prompt(const Frame& F) {
#pragma unroll 1
    for (int j = 2 * F.bid; j < 2 * NB_P * NH * 16; j += ((j & 1) ? 2 * F.G - 1 : 1)) {
        const int item = j >> 1, bh = item >> 4, p = item & 15;
        attn_prompt_unit(F, bh, (j & 1) ? p : 31 - p);
    }
}

DI void cache_tile_to_image(const float* src, LAS uchar* img, int lrow, int lch) {
    const float* p = src + (size_t)lrow * (NH * DH) + lch * 4;
#pragma unroll
    for (int hf = 0; hf < 2; ++hf) {
        f32x4 r[8];
#pragma unroll
        for (int i = 0; i < 8; ++i) r[i] = __builtin_nontemporal_load((const f32x4*)(p + (size_t)(2 * (8 * hf + i)) * (NH * DH)));
#pragma unroll
        for (int i = 0; i < 8; ++i) { const int row = 2 * (8 * hf + i) + lrow;
            *(LAS u32x2*)(img + off_a((unsigned)row, (unsigned)(lch >> 1)) + 8 * (lch & 1)) = (u32x2){pk2(r[i][0], r[i][1]), pk2(r[i][2], r[i][3])}; }
    }
}
DI void attn_sample_unit(const Frame& F, int su) {
    const int lane = F.lane, w = F.wave, h = lane >> 5, c = lane & 31;
    const int b = su >> 3, head = su & 7;
    const FragAddr fa = make_frag_addr(lane);
    LAS uchar* kimg = F.lds + RING_OFF + w * 16384; LAS uchar* vimg = kimg + 8192;
    const float* c2 = wsp<float>(F, WS_C2S) + (size_t)su * SKV_S;
    const int rowq = MP + b * T_S + c;
    bf16x8 qf[8];
#pragma unroll
    for (int ks = 0; ks < 8; ++ks) qf[ks] = (bf16x8){0, 0, 0, 0, 0, 0, 0, 0};
    LAS uchar* qimg = F.lds + QIMG_OFF;
    { const int row = F.tid >> 4, ch = F.tid & 15;
      *(LAS u32x4*)(qimg + off_a((unsigned)row, (unsigned)ch)) = *(const u32x4*)(wsp<bf16>(F, WS_QB) + (size_t)(MP + b * T_S + row) * W1K + head * DH + ch * 8); }
    __syncthreads();
    const float cq2 = c2[PAST + c];
    float m = -1e30f, l = 0.f; f32x16 o[4];
#pragma unroll
    for (int dt = 0; dt < 4; ++dt)
#pragma unroll
        for (int i = 0; i < 16; ++i) o[dt][i] = 0.f;
    bf16x8 pf0, pf1;
    if (w == 0) {
        const bf16* kg = wsp<bf16>(F, WS_KB) + (size_t)(MP + b * T_S) * W1K + head * DH; const bf16* vg = wsp<bf16>(F, WS_VB) + (size_t)(MP + b * T_S) * W1K + head * DH;
#pragma unroll
        for (int i = 0; i < 8; ++i) { const int idx = lane + 64 * i, row = idx >> 4, ch = idx & 15;
            *(LAS u32x4*)(kimg + off_a((unsigned)row, (unsigned)ch)) = *(const u32x4*)(kg + (size_t)row * W1K + ch * 8);
            *(LAS u32x4*)(vimg + off_a((unsigned)row, (unsigned)ch)) = *(const u32x4*)(vg + (size_t)row * W1K + ch * 8); }
        f32x4 ckv[4];
#pragma unroll
        for (int g = 0; g < 4; ++g) ckv[g] = *(const f32x4*)(c2 + PAST + 8 * g + 4 * h);
        if (flash_qk<true>(true, qf, qimg, kimg, 0, ckv, cq2, 0, c, m, l, o, pf0, pf1, lane, fa)) flash_pv(vimg, 0, pf0, pf1, o, fa);
    }
    const float* kb = F.ck + ((size_t)b * PAST * NH + head) * DH; const float* vb = F.cv + ((size_t)b * PAST * NH + head) * DH;
    const int lrow = lane >> 5, lch = lane & 31;
    for (int jt = PAST / 32 - 1 - w; jt >= 0; jt -= NWAVES) {
        f32x4 ckv[4];
#pragma unroll
        for (int g = 0; g < 4; ++g) ckv[g] = *(const f32x4*)(c2 + 32 * jt + 8 * g + 4 * h);
        cache_tile_to_image(kb + (size_t)(32 * jt) * (NH * DH), kimg, lrow, lch);
        if (flash_qk<true>(false, qf, qimg, kimg, 0, ckv, cq2, 0, 0, m, l, o, pf0, pf1, lane, fa)) {
            cache_tile_to_image(vb + (size_t)(32 * jt) * (NH * DH), vimg, lrow, lch);
            flash_pv(vimg, 0, pf0, pf1, o, fa);
        }
    }
    LAS float* ms = (LAS float*)(F.lds + SCR_OFF);
    l += __shfl_xor(l, 32);
    if (h == 0) ms[w * 32 + c] = m;
    __syncthreads();
    float mg = ms[c];
#pragma unroll
    for (int j = 1; j < 8; ++j) mg = fmaxf(mg, ms[j * 32 + c]);
    const float a = fexp2(m - mg);
    if (h == 0) ms[256 + w * 32 + c] = l * a;
    LAS uchar* po = F.lds + RING_OFF + w * 16384;
#pragma unroll
    for (int dt = 0; dt < 4; ++dt)
#pragma unroll
        for (int g = 0; g < 4; ++g) { const unsigned chk = (unsigned)(8 * dt + 2 * g + h) ^ (unsigned)c;
            *(LAS f32x4*)(po + c * 512 + chk * 16) = (f32x4){o[dt][4 * g] * a, o[dt][4 * g + 1] * a, o[dt][4 * g + 2] * a, o[dt][4 * g + 3] * a}; }
    __syncthreads();
    float lt = 0.f;
#pragma unroll
    for (int j = 0; j < 8; ++j) lt += ms[256 + j * 32 + c];
    const float inv = 1.0f / lt;
    f32x4 s0 = {0.f, 0.f, 0.f, 0.f}, s1 = {0.f, 0.f, 0.f, 0.f};
#pragma unroll
    for (int j = 0; j < 8; ++j) { const LAS uchar* pj = F.lds + RING_OFF + j * 16384 + c * 512;
        s0 += *(const LAS f32x4*)(pj + (((unsigned)(4 * w + 2 * h) ^ (unsigned)c) * 16)); s1 += *(const LAS f32x4*)(pj + (((unsigned)(4 * w + 2 * h + 1) ^ (unsigned)c) * 16)); }
    s0 = s0 * inv; s1 = s1 * inv;
    u32x4 ow; ow[0] = pk2(s0[0], s0[1]); ow[1] = pk2(s0[2], s0[3]); ow[2] = pk2(s1[0], s1[1]); ow[3] = pk2(s1[2], s1[3]);
    *(u32x4*)(wsp<bf16>(F, WS_OAB) + (size_t)rowq * 2048 + W1K + head * DH + 16 * w + 8 * h) = ow;
    __syncthreads();
}
DI void p6_attn_sample(const Frame& F) { for (int su = F.bid; su < NB_S * NH; su += F.G) attn_sample_unit(F, su); }

DI void slab_row_sum(const Frame& F, const float* res, int srow, f32x4 (&v)[8]) {
    const f32x4* rv = (const f32x4*)res + F.lane;
#pragma unroll
    for (int j = 0; j < 8; ++j) v[j] = rv[64 * j];
#pragma unroll 2
    for (int ks = 0; ks < 8; ++ks) { const f32x4* sv = (const f32x4*)(wsp<float>(F, WS_T1) + ((size_t)ks * MS + srow) * D_MODEL) + F.lane;
#pragma unroll
        for (int j = 0; j < 8; ++j) v[j] += sv[64 * j]; }
}
DI void p_combine_mg(const Frame& F) {
    const int gw = F.bid * NWAVES + F.wave, NGW = F.G * NWAVES;
    for (int m = gw; m < MS; m += NGW) {
        f32x4 v[8];
#pragma unroll
        for (int j = 0; j < 8; ++j) v[j] = (f32x4){0.f, 0.f, 0.f, 0.f};
#pragma unroll 2
        for (int ks = 0; ks < 8; ++ks) { const f32x4* sv = (const f32x4*)(wsp<float>(F, WS_T1) + ((size_t)ks * MS + m) * D_MODEL) + F.lane;
#pragma unroll
            for (int j = 0; j < 8; ++j) v[j] += sv[64 * j]; }
        u32x2* o8 = (u32x2*)(wsp<bf16>(F, WS_MG) + (size_t)(MP + m) * D_MODEL) + F.lane;
#pragma unroll
        for (int j = 0; j < 8; ++j) o8[64 * j] = (u32x2){pk2(v[j][0], v[j][1]), pk2(v[j][2], v[j][3])};
    }
}
DI void p_norm2(const Frame& F) {
    const int gw = F.bid * NWAVES + F.wave, NGW = F.G * NWAVES;
    for (int m = gw; m < MROWS; m += NGW) {
        float* x1r = wsp<float>(F, WS_X1) + (size_t)m * D_MODEL;
        f32x4 v[8];
        if (m < MP) { const f32x4* xv = (const f32x4*)x1r + F.lane;
#pragma unroll
            for (int j = 0; j < 8; ++j) v[j] = xv[64 * j]; }
        else { slab_row_sum(F, F.x_s + (size_t)(m - MP) * D_MODEL, m - MP, v);
#pragma unroll
            for (int j = 0; j < 8; ++j) ((f32x4*)x1r + F.lane)[64 * j] = v[j]; }
        float s = 0.f;
#pragma unroll
        for (int j = 0; j < 8; ++j) s += (v[j][0] * v[j][0] + v[j][1] * v[j][1]) + (v[j][2] * v[j][2] + v[j][3] * v[j][3]);
        const float rstd = 1.0f / sqrtf(wave_sum(s) * (1.0f / D_MODEL) + EPS);
        u32x2* o8 = (u32x2*)(wsp<bf16>(F, WS_H) + (size_t)m * D_MODEL) + F.lane; const f32x4* gv = (const f32x4*)F.norm2 + F.lane;
#pragma unroll
        for (int j = 0; j < 8; ++j) { const f32x4 hh = v[j] * rstd * gv[64 * j]; o8[64 * j] = (u32x2){pk2(hh[0], hh[1]), pk2(hh[2], hh[3])}; }
    }
}
DI void p_norm_final(const Frame& F) {
    const int gw = F.bid * NWAVES + F.wave, NGW = F.G * NWAVES;
    for (int m = gw; m < MROWS; m += NGW) {
        f32x4* xv = (f32x4*)(F.out + OUT_Y + (size_t)m * D_MODEL) + F.lane; const f32x4* gv = (const f32x4*)F.norm_f + F.lane;
        f32x4 v[8]; float s = 0.f;
        if (m < MP) {
#pragma unroll
            for (int j = 0; j < 8; ++j) v[j] = xv[64 * j]; }
        else slab_row_sum(F, wsp<float>(F, WS_X1) + (size_t)m * D_MODEL, m - MP, v);
#pragma unroll
        for (int j = 0; j < 8; ++j) s += (v[j][0] * v[j][0] + v[j][1] * v[j][1]) + (v[j][2] * v[j][2] + v[j][3] * v[j][3]);
        const float rstd = 1.0f / sqrtf(wave_sum(s) * (1.0f / D_MODEL) + EPS);
#pragma unroll
        for (int j = 0; j < 8; ++j) xv[64 * j] = v[j] * rstd * gv[64 * j];
    }
}

constexpr int N_PHASES = 14;
struct Args { const float* in[18]; float* out; uchar* ws; int ph_lo, ph_hi; };
__global__ void __launch_bounds__(NWAVES * 64, 2) fwd_kernel(Args args) {
    extern __shared__ __attribute__((aligned(16))) uchar lds_raw[];
    Frame F;
    F.lds = (LAS uchar*)lds_raw;
    F.tid = threadIdx.x; F.lane = F.tid & 63; F.wave = __builtin_amdgcn_readfirstlane(F.tid >> 6);
    F.G = gridDim.x; F.bid = blockIdx.x;
    F.x_p = args.in[0]; F.x_s = args.in[1]; F.ck = args.in[2]; F.cv = args.in[3]; F.clf = args.in[4]; F.st0 = args.in[5]; F.norm1 = args.in[6]; F.w_in = args.in[7]; F.b_fox = args.in[8];
    F.lb_logits = args.in[9]; F.gnorm = args.in[10]; F.w_pa = args.in[11]; F.w_pb = args.in[12]; F.w_o = args.in[13]; F.norm2 = args.in[14]; F.w1 = args.in[15]; F.w2 = args.in[16]; F.norm_f = args.in[17];
    F.out = args.out; F.ws = args.ws;
    for (int u = F.tid; u < (LDS_BYTES - LDSCTL_OFF) / 4; u += NWAVES * 64) ((LAS unsigned*)(F.lds + LDSCTL_OFF))[u] = 0u;
    __syncthreads();
    const int lo = args.ph_lo, hi = args.ph_hi;
    const bool multi = (hi - lo) > 1;
    XcdBarrier bar; bar.bar = (unsigned*)(F.ws + WS_CTL) + CW_BAR; bar.x = 0; bar.st = nullptr;
    if (multi) bar = xcd_barrier_post((unsigned*)(F.ws + WS_CTL) + CW_BAR, (volatile LAS unsigned*)(F.lds + MISC_OFF) + 8);
#ifndef PH_MASK
#define PH_MASK 0xffffffffu
#endif
#define IN(k) (((PH_MASK >> (k)) & 1u) && lo <= (k) && (k) < hi)
#define SEAM(k) do { if (IN(k) && IN((k) + 1)) xcd_barrier(bar); } while (0)
#ifndef DUP_MASK
#define DUP_MASK 0u
#endif
#define RUNPH(k, ...) if (IN(k)) { __VA_ARGS__ if ((DUP_MASK >> (k)) & 1u) { xcd_barrier(bar); __VA_ARGS__ } }
    LAS uchar* ring = F.lds + RING_OFF;

    RUNPH(0, { p0_prologue(F); }) SEAM(0);
    RUNPH(1, {
        pg8::Gemm g{wsp<bf16>(F, WS_H), wsp<bf16>(F, WS_WIN), MROWS, N_INP, D_MODEL}; pg8::InProjOrder S; S.init(F.G, F.bid);
        pg8::EpiInProj E{F.ws, F.out};
        pg8::gemm_phase<pg8::EpiInProj, pg8::InProjOrder, true, true>(ring, g, S, E);
        if (F.bid >= 192) { const int task = (F.bid - 192) * NWAVES + F.wave; if (task < N_SCAN_TASKS) scan_task(F, task); }
    }) SEAM(1);
    RUNPH(2, { p_combine_gate(F); p_attn_stats(F); p3_hgrn_local(F); }) SEAM(2);
    RUNPH(3, { p4_hgrn_scan(F); }) SEAM(3);
    RUNPH(4, { p5_hgrn_out(F); }) SEAM(4);
    RUNPH(5, { p6_attn_prompt(F); }) SEAM(5);
    RUNPH(6, { p6_attn_sample(F); }) SEAM(6);
    RUNPH(7, {
        pg8::Gemm g{wsp<bf16>(F, WS_OAB), wsp<bf16>(F, WS_WP), MROWS, D_MODEL, D_MODEL}; pg8::SplitOrder S; S.init(D_MODEL, D_MODEL, F.G, F.bid, 8);
        pg8::EpiMerge E{wsp<bf16>(F, WS_G), wsp<bf16>(F, WS_MG), wsp<float>(F, WS_T1)};
        pg8::gemm_phase<pg8::EpiMerge, pg8::SplitOrder, true, true>(ring, g, S, E);
    }) SEAM(7);
    RUNPH(8, { p_combine_mg(F); }) SEAM(8);
    RUNPH(9, {
        pg8::Gemm g{wsp<bf16>(F, WS_MG), wsp<bf16>(F, WS_WO), MROWS, D_MODEL, D_MODEL}; pg8::SplitOrder S; S.init(D_MODEL, D_MODEL, F.G, F.bid, 8);
        pg8::EpiResid E{F.x_p, wsp<float>(F, WS_X1), wsp<float>(F, WS_T1)};
        pg8::gemm_phase<pg8::EpiResid, pg8::SplitOrder, true, true>(ring, g, S, E);
    }) SEAM(9);
    RUNPH(10, { p_norm2(F); }) SEAM(10);
    RUNPH(11, {
        pg8::Gemm g{wsp<bf16>(F, WS_H), wsp<bf16>(F, WS_W1), MROWS, D_FF, D_MODEL}; pg8::StaticOrder S; S.init(MROWS, D_FF, F.G, F.bid);
        pg8::EpiMix<2> E{nullptr, nullptr, wsp<bf16>(F, WS_U), D_FF};
        pg8::gemm_phase<pg8::EpiMix<2>, pg8::StaticOrder, true, true>(ring, g, S, E);
    }) SEAM(11);
    RUNPH(12, {
        pg8::Gemm g{wsp<bf16>(F, WS_U), wsp<bf16>(F, WS_W2), MROWS, D_MODEL, D_FF}; pg8::SplitOrder S; S.init(D_MODEL, D_FF, F.G, F.bid, 8);
        pg8::EpiResid E{wsp<float>(F, WS_X1), F.out + OUT_Y, wsp<float>(F, WS_T1)};
        pg8::gemm_phase<pg8::EpiResid, pg8::SplitOrder, true, true>(ring, g, S, E);
    }) SEAM(12);
    RUNPH(13, { p_norm_final(F); })
#undef IN
#undef SEAM
}

#ifndef MK_ONE_LAUNCH
#define MK_ONE_LAUNCH 1
#endif
extern "C" void kernel_launch(void* const* d_in, const int* in_sizes, int n_in, void* d_out, int out_size, void* d_ws, size_t ws_size, hipStream_t stream) {
    static int grid = 0;
    if (grid == 0) {
        if (n_in != 18 || (size_t)out_size != OUT_END || ws_size < WS_END) { fprintf(stderr, "kernel_launch: unexpected sizes: n_in %d out %d ws %zu (need out %zu ws %zu)\n", n_in, out_size, ws_size, (size_t)OUT_END, (size_t)WS_END); grid = -1; return; }
        int dev = 0, cus = 0, per_cu = 0;
        if (hipGetDevice(&dev) != hipSuccess || hipDeviceGetAttribute(&cus, hipDeviceAttributeMultiprocessorCount, dev) != hipSuccess) { grid = -1; return; }
        if (hipFuncSetAttribute((const void*)fwd_kernel, hipFuncAttributeMaxDynamicSharedMemorySize, LDS_BYTES) != hipSuccess) { fprintf(stderr, "kernel_launch: hipFuncSetAttribute failed\n"); grid = -1; return; }
        if (hipOccupancyMaxActiveBlocksPerMultiprocessor(&per_cu, (const void*)fwd_kernel, NWAVES * 64, LDS_BYTES) != hipSuccess || per_cu < 1)
            fprintf(stderr, "kernel_launch: note: occupancy query reports %d workgroups per CU\n", per_cu);
        (void)hipGetLastError();
        grid = cus;
    }
    if (grid < 0) return;
    if (hipMemsetAsync((char*)d_ws + WS_CTL, 0, CTL_ZERO_BYTES, stream) != hipSuccess) { fprintf(stderr, "kernel_launch: memset failed\n"); return; }
    Args a{};
    for (int i = 0; i < 18; ++i) a.in[i] = (const float*)d_in[i];
    a.out = (float*)d_out; a.ws = (uchar*)d_ws;
#if MK_ONE_LAUNCH
    a.ph_lo = 0; a.ph_hi = N_PHASES;
    hipLaunchKernelGGL(fwd_kernel, dim3(grid), dim3(NWAVES * 64), LDS_BYTES, stream, a);
#else
    for (int p = 0; p < N_PHASES; ++p) { a.ph_lo = p; a.ph_hi = p + 1; hipLaunchKernelGGL(fwd_kernel, dim3(grid), dim3(NWAVES * 64), LDS_BYTES, stream, a); }
#endif
    const hipError_t le = hipPeekAtLastError();
    if (le != hipSuccess) fprintf(stderr, "kernel_launch: launch failed: %s\n", hipGetErrorName(le));
}
```

```cpp
#include <hip/hip_runtime.h>
#include <cstdio>
#include <cstdint>

constexpr int D_MODEL = 2048, SEQ = 4096, NB_P = 2, NB_S = 32, T_S = 32, PAST = 4096;
constexpr int MP = NB_P * SEQ;
constexpr int MS = NB_S * T_S;
constexpr int MROWS = MP + MS;
constexpr int NH = 8, DH = 128, W1K = 1024;
constexpr int D_FF = 8192;
constexpr int N_IN = 11272;
constexpr int N_INP = 11264;
constexpr int COL_FL = 7168;
constexpr int CHK = 32;
constexpr int NCH = SEQ / CHK;
constexpr int NU_P = NB_P * NH * NCH;
constexpr int NU_S = NB_S * NH;
constexpr int NU = NU_P + NU_S;
constexpr int SKV_S = PAST + T_S;
constexpr float EPS = 1e-6f;
constexpr float LOG2E = 1.4426950408889634f;
constexpr float QSCALE = 0.08838834764831845f * LOG2E;

#define GAS __attribute__((address_space(1)))
#define LAS __attribute__((address_space(3)))
#define DI __device__ __forceinline__
typedef unsigned short bf16;
typedef unsigned char uchar;
typedef short bf16x8 __attribute__((ext_vector_type(8)));
typedef short s16x4 __attribute__((ext_vector_type(4)));
typedef float f32x2 __attribute__((ext_vector_type(2)));
typedef float f32x4 __attribute__((ext_vector_type(4)));
typedef float f32x16 __attribute__((ext_vector_type(16)));
typedef unsigned u32x2 __attribute__((ext_vector_type(2)));
typedef unsigned u32x4 __attribute__((ext_vector_type(4)));
typedef __bf16 nbf2 __attribute__((ext_vector_type(2)));

DI unsigned pk2(float lo, float hi) { f32x2 x = {lo, hi}; nbf2 y = __builtin_convertvector(x, nbf2); return __builtin_bit_cast(unsigned, y); }
DI float bf_lo(unsigned u) { return __uint_as_float(u << 16); }
DI float bf_hi(unsigned u) { return __uint_as_float(u & 0xffff0000u); }
DI float fexp2(float x) { return __builtin_amdgcn_exp2f(x); }
DI float fexp(float x) { return __builtin_amdgcn_exp2f(x * LOG2E); }
DI float frcp(float x) { return __builtin_amdgcn_rcpf(x); }
DI float flog(float x) { return __builtin_amdgcn_logf(x) * 0.6931471805599453f; }
DI float fsigmoid(float x) { return frcp(1.0f + fexp(-x)); }
DI float fsilu(float x) { return x * fsigmoid(x); }
DI float wave_sum(float v) {
#pragma unroll
    for (int o = 1; o < 64; o <<= 1) v += __shfl_xor(v, o);
    return v;
}
#define MFMA32(a, b, c) __builtin_amdgcn_mfma_f32_32x32x16_bf16((a), (b), (c), 0, 0, 0)

DI unsigned off_a(unsigned row, unsigned ch) { return 2048u * (row >> 3) + 512u * (ch >> 2) + 64u * (row & 7u) + 16u * ((ch & 3u) ^ ((row >> 2) & 3u)); }
struct FragAddr { unsigned row_e, row_o, trn0, trn1, trp0, trp1; };
DI FragAddr make_frag_addr(int lane) {
    FragAddr a; const unsigned r = lane & 31, h = lane >> 5, blk = (lane >> 4) & 1, q = (lane & 15) >> 2, p = lane & 3;
    a.row_e = off_a(r, h); a.row_o = off_a(r, 2 + h);
    const unsigned ch = 2 * blk + (p >> 1);
    a.trn0 = off_a(8 * h + q, ch) + 8 * (p & 1); a.trn1 = off_a(8 * h + q + 4, ch) + 8 * (p & 1);
    a.trp0 = off_a(4 * h + q, ch) + 8 * (p & 1); a.trp1 = off_a(4 * h + q + 8, ch) + 8 * (p & 1);
    return a;
}
DI bf16x8 frag_row(LAS uchar* img, const FragAddr& fa, int R0, int s) { return *(LAS bf16x8*)(img + ((s & 1) ? fa.row_o : fa.row_e) + 256 * R0 + 512 * (s >> 1)); }
template <bool PERM> DI bf16x8 frag_tr(LAS uchar* img, const FragAddr& fa, int K0, int c, int ks) {
    const int imm = 256 * K0 + 4096 * ks + 512 * c;
    const s16x4 lo = __builtin_amdgcn_ds_read_tr16_b64_v4i16((LAS s16x4*)(img + (PERM ? fa.trp0 : fa.trn0) + imm));
    const s16x4 hi = __builtin_amdgcn_ds_read_tr16_b64_v4i16((LAS s16x4*)(img + (PERM ? fa.trp1 : fa.trn1) + imm));
    return (bf16x8){lo[0], lo[1], lo[2], lo[3], hi[0], hi[1], hi[2], hi[3]};
}
DI bf16x8 pack_acc(const f32x16& x, int s) {
    u32x4 p;
    p[0] = pk2(x[8 * s + 0], x[8 * s + 1]); p[1] = pk2(x[8 * s + 2], x[8 * s + 3]); p[2] = pk2(x[8 * s + 4], x[8 * s + 5]); p[3] = pk2(x[8 * s + 6], x[8 * s + 7]);
    return __builtin_bit_cast(bf16x8, p);
}

constexpr size_t MiB = 1u << 20;
constexpr size_t WS_CTL = 0, CTL_ZERO_BYTES = 1 * MiB;
constexpr size_t WS_WIN = 2 * MiB;
constexpr size_t WS_WP = 46 * MiB;
constexpr size_t WS_WO = 54 * MiB;
constexpr size_t WS_W1 = 62 * MiB;
constexpr size_t WS_W2 = 94 * MiB;
constexpr size_t WS_H = 126 * MiB;
constexpr size_t WS_QA = 162 * MiB, WS_VA = 180 * MiB, WS_GA = 198 * MiB, WS_QB = 216 * MiB, WS_KB = 234 * MiB, WS_VB = 252 * MiB;
constexpr size_t WS_LFA = 270 * MiB;
constexpr size_t WS_G = 306 * MiB;
constexpr size_t WS_LFB = 378 * MiB;
constexpr size_t WS_LB = 379 * MiB;
constexpr size_t WS_C2P = 380 * MiB;
constexpr size_t WS_C2S = 381 * MiB;
constexpr size_t WS_QN = 379 * MiB + 65536;
constexpr size_t WS_SSP = 956 * MiB;
constexpr size_t WS_DEC = 386 * MiB;
constexpr size_t WS_DS = 388 * MiB;
constexpr size_t WS_SP = 532 * MiB;
constexpr size_t WS_OAB = 596 * MiB;
constexpr size_t WS_T1 = 632 * MiB;
constexpr size_t WS_MG = 704 * MiB;
constexpr size_t WS_X1 = 740 * MiB;
constexpr size_t WS_U = 812 * MiB;
constexpr size_t WS_END = 958 * MiB;
constexpr int CW_BAR = 4096;
constexpr int CW_SUMSQ = 32768;
constexpr int CW_KMAX = 16384;
constexpr size_t OUT_Y = 0, OUT_KP = (size_t)MROWS * 2048, OUT_VP = OUT_KP + (size_t)MP * 1024, OUT_LFP = OUT_VP + (size_t)MP * 1024, OUT_SP = OUT_LFP + (size_t)MP * 8,
                 OUT_KS = OUT_SP + (size_t)NB_P * NH * 128 * 128, OUT_VS = OUT_KS + (size_t)MS * 1024, OUT_LFS = OUT_VS + (size_t)MS * 1024, OUT_SS = OUT_LFS + (size_t)MS * 8,
                 OUT_END = OUT_SS + (size_t)NB_S * NH * 128 * 128;
constexpr int NWAVES = 8;
constexpr int RING_OFF = 0, RING_BYTES = 131072;
constexpr int LDSCTL_OFF = RING_BYTES, MISC_OFF = LDSCTL_OFF + 320;
constexpr int SCR_OFF = RING_BYTES + 1024;
constexpr int QIMG_OFF = SCR_OFF + 8192;
constexpr int LDS_BYTES = 163840;

#define RLX_AGENT __ATOMIC_RELAXED, __HIP_MEMORY_SCOPE_AGENT
namespace pg8 {
#define PG8_LAS __attribute__((address_space(3)))
typedef unsigned short bf16_t;
typedef short bf16x8 __attribute__((ext_vector_type(8)));
typedef float f32x4 __attribute__((ext_vector_type(4)));
typedef unsigned u32x4 __attribute__((ext_vector_type(4)));
constexpr int BM = 256, BK = 64, HALF = 128, HTB = HALF * BK * 2  , STAGE_BYTES = 8 * HTB, NXCD = 8, WGM = 8;

__host__ __device__ __forceinline__ int lds_byte(int r, int c) { const int st = (r >> 4) * 2 + (c >> 5), rr = r & 15, cc = c & 31, ob = rr * 64 + cc * 2; return st * 1024 + (ob ^ (((ob >> 9) & 1) << 5)); }
__host__ __device__ __forceinline__ void stage_rc(int b, int& R, int& C) { const int st = b / 1024, sb = b % 1024, swz = sb ^ (((sb >> 9) & 1) << 5); R = (st >> 1) * 16 + swz / 64; C = (st & 1) * 32 + (swz % 64) / 2; }
__host__ __device__ __forceinline__ int perm32(int rho) { const int n = rho >> 4, i = rho & 15; return 8 * (i >> 2) + 4 * n + (i & 3); }

struct Unit { int pm, pn, k0, nt, ks; };
struct Gemm { const bf16_t* A; const bf16_t* Bt; int M, N, K; };

struct StaticOrder {
    int nM, nN, nwg, G, c;
    __host__ __device__ __forceinline__ void init(int M, int N, int G_, int c_) { nM = M / BM; nN = N / BM; nwg = nM * nN; G = G_; c = c_; }
    __host__ __device__ __forceinline__ void map(int wgid, int& pm, int& pn) const {
        { const int q = nwg / NXCD, r = nwg % NXCD, xcd = wgid % NXCD, off = wgid / NXCD; wgid = (xcd < r ? xcd * (q + 1) : r * (q + 1) + (xcd - r) * q) + off; }
        const int nig = WGM * nN, gid = wgid / nig, fm = gid * WGM, gsz = (nM - fm) < WGM ? (nM - fm) : WGM;
        pm = fm + ((wgid % nig) % gsz); pn = (wgid % nig) / gsz;
    }
    __host__ __device__ __forceinline__ bool next(int i, Unit& u) const {
        const long L = (long)i * G + c; if (L >= nwg) return false;
        int pm, pn; map((int)L, pm, pn);
        u = Unit{pm, pn, 0, 0, -1}; return true;
    }
    __device__ __forceinline__ void a_ready(const Unit&) const {}
    __device__ __forceinline__ void done(const Unit&) const {}
};


template <class Epi, class Sched, bool ALIGN_EPI = false, bool SP2 = false>
__device__ __forceinline__ void gemm_phase(PG8_LAS unsigned char* lds, const Gemm g, const Sched& S, const Epi& E) {
    const int tid = threadIdx.x, wid = __builtin_amdgcn_readfirstlane(tid >> 6), lane = tid & 63, wr = wid >> 2, wc = wid & 3, fr = lane & 15, fq = lane >> 4;
    const int K = g.K;
    unsigned voffA[2], voffB[2];
#pragma unroll
    for (int i = 0; i < 2; ++i) { int R, C; stage_rc(tid * 16 + i * 8192, R, C); const int Rb = Epi::PERM ? ((R & ~31) + perm32(R & 31)) : R;
        voffA[i] = (unsigned)(R * K + C) * 2u; voffB[i] = (unsigned)(Rb * K + C) * 2u; }
    const size_t kstep = (size_t)(BK * 2);
    const size_t hstep = (size_t)HALF * K * 2;
    const size_t tstep = 2 * hstep;
    const unsigned ldsw = (unsigned)wid * 1024u;
    const int aoff = lds_byte(wr * 64 + fr, fq * 8), boff = lds_byte(wc * 32 + fr, fq * 8);
#define PG8_SA(b, h) (((b) * 2 + (h)) * HTB)
#define PG8_SB(b, h) ((4 + (b) * 2 + (h)) * HTB)
#define PG8_STAGE(bufoff, gbase, voff) do { _Pragma("unroll") for (int _i = 0; _i < 2; ++_i) \
        __builtin_amdgcn_global_load_lds((const unsigned*)((const char*)(gbase) + (voff)[_i]), (PG8_LAS unsigned*)(lds + (bufoff) + ldsw + _i * 8192), 16, 0, 0); } while (0)
#define PG8_LDA(dst, b, h) do { _Pragma("unroll") for (int m = 0; m < 4; ++m) _Pragma("unroll") for (int k = 0; k < 2; ++k) dst[m][k] = *(const PG8_LAS bf16x8*)(lds + PG8_SA(b, h) + aoff + m * 2048 + k * 1024); } while (0)
#define PG8_LDB(dst, b, h) do { _Pragma("unroll") for (int n = 0; n < 2; ++n) _Pragma("unroll") for (int k = 0; k < 2; ++k) dst[n][k] = *(const PG8_LAS bf16x8*)(lds + PG8_SB(b, h) + boff + n * 2048 + k * 1024); } while (0)
#define PG8_MMA(ai, bj, At, Bt) do { __builtin_amdgcn_s_setprio(1); _Pragma("unroll") for (int m = 0; m < 4; ++m) _Pragma("unroll") for (int n = 0; n < 2; ++n) _Pragma("unroll") for (int k = 0; k < 2; ++k) \
        acc[ai][bj][m][n] = __builtin_amdgcn_mfma_f32_16x16x32_bf16(Bt[n][k], At[m][k], acc[ai][bj][m][n], 0, 0, 0); __builtin_amdgcn_s_setprio(0); } while (0)
#define PG8_WAIT_V(n) asm volatile("s_waitcnt vmcnt(" #n ")" ::: "memory")
#define PG8_WAIT_L(n) asm volatile("s_waitcnt lgkmcnt(" #n ")" ::: "memory")
#define PG8_BAR __builtin_amdgcn_s_barrier()
#define PG8_SCHED __builtin_amdgcn_sched_barrier(0)
    Unit cur, nxt; int ui = 0;
    if (!S.next(0, cur)) return;
    f32x4 acc[2][2][4][2];
#pragma unroll
    for (int a = 0; a < 2; ++a)
#pragma unroll
        for (int b = 0; b < 2; ++b)
#pragma unroll
            for (int m = 0; m < 4; ++m)
#pragma unroll
                for (int n = 0; n < 2; ++n) acc[a][b][m][n] = (f32x4){0.f, 0.f, 0.f, 0.f};
    bf16x8 At[4][2], B0[2][2], B1[2][2];
    const char* cA = (const char*)g.A + (size_t)cur.pm * tstep + (size_t)cur.k0 * kstep; const char* cB = (const char*)g.Bt + (size_t)cur.pn * tstep + (size_t)cur.k0 * kstep;
    S.a_ready(cur);
    if constexpr (SP2) {
        PG8_STAGE(PG8_SB(0, 0), cB, voffB); PG8_STAGE(PG8_SB(0, 1), cB + hstep, voffB); PG8_STAGE(PG8_SA(0, 0), cA, voffA); PG8_STAGE(PG8_SA(0, 1), cA + hstep, voffA);
        if (wr == 1) PG8_BAR;
        PG8_WAIT_V(2); PG8_BAR;
        PG8_STAGE(PG8_SB(1, 0), cB + kstep, voffB); PG8_STAGE(PG8_SA(1, 0), cA + kstep, voffA); PG8_STAGE(PG8_SB(1, 1), cB + hstep + kstep, voffB);
        PG8_WAIT_V(6); PG8_BAR;
    } else {
        PG8_STAGE(PG8_SB(0, 0), cB, voffB); PG8_STAGE(PG8_SA(0, 0), cA, voffA); PG8_STAGE(PG8_SB(0, 1), cB + hstep, voffB); PG8_STAGE(PG8_SA(0, 1), cA + hstep, voffA);
        if (wr == 1) PG8_BAR;
        PG8_WAIT_V(4); PG8_BAR;
        PG8_STAGE(PG8_SB(1, 0), cB + kstep, voffB); PG8_STAGE(PG8_SA(1, 0), cA + kstep, voffA); PG8_STAGE(PG8_SB(1, 1), cB + hstep + kstep, voffB);
        PG8_WAIT_V(6); PG8_BAR;
    }
    for (;;) {
        const bool has_next = S.next(ui + 1, nxt);
        const char* nA = has_next ? (const char*)g.A + (size_t)nxt.pm * tstep + (size_t)nxt.k0 * kstep : cA; const char* nB = has_next ? (const char*)g.Bt + (size_t)nxt.pn * tstep + (size_t)nxt.k0 * kstep : cB;
        const int nt = cur.nt ? cur.nt : K / BK;
        for (int t = 0; t < nt; t += 2) {
            if constexpr (Epi::MID) { if (t == E.tmid(cur)) E.mid(acc, cur, wr, wc, fr, fq); }
            const bool last = (t == nt - 2);
            const char* a1 = cA + (size_t)(t + 1) * kstep;
            const char* a2 = last ? nA : cA + (size_t)(t + 2) * kstep; const char* b2 = last ? nB : cB + (size_t)(t + 2) * kstep;
            const char* a3 = a2 + kstep; const char* b3 = b2 + kstep;
            if (last && has_next) S.a_ready(nxt);
            if constexpr (SP2) {
            PG8_LDB(B0, 0, 0); PG8_LDB(B1, 0, 1); PG8_SCHED; PG8_LDA(At, 0, 0); PG8_STAGE(PG8_SA(1, 1), a1 + hstep, voffA);
            PG8_WAIT_V(8); PG8_WAIT_L(0); PG8_BAR; PG8_MMA(0, 0, At, B0); PG8_MMA(0, 1, At, B1); PG8_BAR; PG8_SCHED;
            PG8_LDA(At, 0, 1); PG8_STAGE(PG8_SB(0, 0), b2, voffB); PG8_STAGE(PG8_SB(0, 1), b2 + hstep, voffB); PG8_STAGE(PG8_SA(0, 0), a2, voffA);
            PG8_WAIT_V(8); PG8_WAIT_L(0); PG8_BAR; PG8_MMA(1, 0, At, B0); PG8_MMA(1, 1, At, B1); PG8_BAR; PG8_SCHED;
            PG8_LDB(B0, 1, 0); PG8_LDB(B1, 1, 1); PG8_SCHED; PG8_LDA(At, 1, 0); PG8_STAGE(PG8_SA(0, 1), a2 + hstep, voffA);
            PG8_WAIT_V(8); PG8_WAIT_L(0); PG8_BAR; PG8_MMA(0, 0, At, B0); PG8_MMA(0, 1, At, B1); PG8_BAR; PG8_SCHED;
            PG8_LDA(At, 1, 1); PG8_STAGE(PG8_SB(1, 0), b3, voffB); PG8_STAGE(PG8_SB(1, 1), b3 + hstep, voffB); PG8_STAGE(PG8_SA(1, 0), a3, voffA);
            PG8_WAIT_V(8); PG8_WAIT_L(0); PG8_BAR; PG8_MMA(1, 0, At, B0); PG8_MMA(1, 1, At, B1); PG8_BAR; PG8_SCHED;
            } else {
            PG8_LDB(B0, 0, 0); PG8_SCHED; PG8_LDA(At, 0, 0); PG8_STAGE(PG8_SA(1, 1), a1 + hstep, voffA);
            PG8_WAIT_L(8); PG8_BAR; PG8_WAIT_L(0); PG8_MMA(0, 0, At, B0); PG8_BAR; PG8_SCHED;
            PG8_LDB(B1, 0, 1); PG8_STAGE(PG8_SB(0, 0), b2, voffB);
            PG8_BAR; PG8_WAIT_L(0); PG8_MMA(0, 1, At, B1); PG8_BAR;
            PG8_LDA(At, 0, 1); PG8_STAGE(PG8_SA(0, 0), a2, voffA);
            PG8_BAR; PG8_WAIT_L(0); PG8_MMA(1, 0, At, B0); PG8_BAR; PG8_SCHED;
            PG8_STAGE(PG8_SB(0, 1), b2 + hstep, voffB);
            PG8_WAIT_V(6); PG8_BAR; PG8_MMA(1, 1, At, B1); PG8_BAR;
            PG8_LDB(B0, 1, 0); PG8_SCHED; PG8_LDA(At, 1, 0); PG8_STAGE(PG8_SA(0, 1), a2 + hstep, voffA);
            PG8_WAIT_L(8); PG8_BAR; PG8_WAIT_L(0); PG8_MMA(0, 0, At, B0); PG8_BAR; PG8_SCHED;
            PG8_LDB(B1, 1, 1); PG8_STAGE(PG8_SB(1, 0), b3, voffB);
            PG8_BAR; PG8_WAIT_L(0); PG8_MMA(0, 1, At, B1); PG8_BAR;
            PG8_LDA(At, 1, 1); PG8_STAGE(PG8_SA(1, 0), a3, voffA);
            PG8_BAR; PG8_WAIT_L(0); PG8_MMA(1, 0, At, B0); PG8_BAR; PG8_SCHED;
            PG8_STAGE(PG8_SB(1, 1), b3 + hstep, voffB);
            PG8_WAIT_V(6); PG8_BAR; PG8_MMA(1, 1, At, B1); PG8_BAR;
            }
        }
        if constexpr (ALIGN_EPI) { if (wr == 0) PG8_BAR; }
        if constexpr (!Epi::AFTER_DRAIN) { E(acc, cur, wr, wc, fr, fq); S.done(cur); }
        if (!has_next) break;
#pragma unroll
        for (int a = 0; a < 2; ++a)
#pragma unroll
            for (int b = 0; b < 2; ++b)
#pragma unroll
                for (int m = 0; m < 4; ++m)
#pragma unroll
                    for (int n = 0; n < 2; ++n) acc[a][b][m][n] = (f32x4){0.f, 0.f, 0.f, 0.f};
        cur = nxt; cA = nA; cB = nB; ++ui;
        if constexpr (ALIGN_EPI) { if (wr == 1) PG8_BAR; }
    }
    PG8_WAIT_V(0);
    if constexpr (!ALIGN_EPI) { if (wr == 0) PG8_BAR; }
    PG8_BAR;
    if constexpr (Epi::AFTER_DRAIN) { E.fused(acc, cur, wr, wc, fr, fq, lds, wid, lane); S.done(cur); }
#undef PG8_SA
#undef PG8_SB
#undef PG8_STAGE
#undef PG8_LDA
#undef PG8_LDB
#undef PG8_MMA
#undef PG8_WAIT_V
#undef PG8_WAIT_L
#undef PG8_BAR
#undef PG8_SCHED
}
}

namespace pg8 {
DI void unpack8(const u32x4 w, float (&f)[8]) { f[0] = bf_lo(w[0]); f[1] = bf_hi(w[0]); f[2] = bf_lo(w[1]); f[3] = bf_hi(w[1]); f[4] = bf_lo(w[2]); f[5] = bf_hi(w[2]); f[6] = bf_lo(w[3]); f[7] = bf_hi(w[3]); }

struct EpiInProj {
    static constexpr bool PERM = true, AFTER_DRAIN = false, MID = false;
    uchar* ws; float* out;
    DI void operator()(const f32x4 (&acc)[2][2][4][2], const Unit& u0, int wr, int wc, int fr, int fq) const {
        Unit u = u0; asm volatile("" : "+s"(u.pm), "+s"(u.pn));
        { int ln; asm volatile("v_mbcnt_lo_u32_b32 %0, -1, 0\n\tv_mbcnt_hi_u32_b32 %0, -1, %0" : "=v"(ln)); fr = ln & 15; fq = ln >> 4; }
        if (u.ks >= 0) {
            float* sl = (float*)(ws + WS_T1) + (size_t)u.ks * (768u * 4096u) + (size_t)((u.pm - 33) * BM + wr * 64 + fr) * 4096 + (u.pn - 28) * BM + wc * 32 + 8 * fq;
#pragma unroll
            for (int ai = 0; ai < 2; ++ai)
#pragma unroll
                for (int m = 0; m < 4; ++m)
#pragma unroll
                    for (int bj = 0; bj < 2; ++bj) { float* t = sl + (size_t)(ai * HALF + m * 16) * 4096 + bj * HALF; *(f32x4*)t = acc[ai][bj][m][0]; *(f32x4*)(t + 4) = acc[ai][bj][m][1]; }
            return;
        }
        const int grp = u.pn < 28 ? (u.pn >> 2) : 7;
        const int ld = (grp == 7) ? 4096 : 1024;
        const int cg0 = ((grp == 7) ? (u.pn - 28) : (u.pn & 3)) * BM + wc * 32 + 8 * fq;
        const size_t oboff = grp == 0 ? WS_QA : grp == 1 ? WS_LFA : grp == 2 ? WS_VA : grp == 3 ? WS_GA : grp == 4 ? WS_QB : grp == 5 ? WS_KB : grp == 6 ? WS_VB : WS_G;
        uchar* ob = ws + oboff;
        float* of = out + ((grp == 5) ? ((u.pm < 32) ? OUT_KP : OUT_KS - (size_t)MP * 1024) : ((u.pm < 32) ? OUT_VP : OUT_VS - (size_t)MP * 1024));
        float lb[2][8];
#pragma unroll
        for (int bj = 0; bj < 2; ++bj)
#pragma unroll
            for (int e = 0; e < 8; ++e) lb[bj][e] = 0.f;
        if (grp == 1) { const float* LB = (const float*)(ws + WS_LB);
#pragma unroll
            for (int bj = 0; bj < 2; ++bj) { const f32x4 a = *(const f32x4*)(LB + cg0 + bj * HALF), b = *(const f32x4*)(LB + cg0 + bj * HALF + 4);
                lb[bj][0] = a[0]; lb[bj][1] = a[1]; lb[bj][2] = a[2]; lb[bj][3] = a[3]; lb[bj][4] = b[0]; lb[bj][5] = b[1]; lb[bj][6] = b[2]; lb[bj][7] = b[3]; }
        }
#pragma unroll
        for (int ai = 0; ai < 2; ++ai)
#pragma unroll
            for (int m = 0; m < 4; ++m) {
                const size_t roff = (size_t)(u.pm * BM + wr * 64 + fr + ai * HALF + m * 16) * ld + cg0;
#pragma unroll
                for (int bj = 0; bj < 2; ++bj) {
                    float v[8];
#pragma unroll
                    for (int e = 0; e < 4; ++e) { v[e] = acc[ai][bj][m][0][e]; v[4 + e] = acc[ai][bj][m][1][e]; }
                    if (grp == 5 || grp == 6) { *(f32x4*)(of + roff + bj * HALF) = acc[ai][bj][m][0]; *(f32x4*)(of + roff + bj * HALF + 4) = acc[ai][bj][m][1]; }
                    if (grp == 0 || grp == 3) {
#pragma unroll
                        for (int e = 0; e < 8; ++e) v[e] = fsilu(v[e]);
                    } else if (grp == 1) {
#pragma unroll
                        for (int e = 0; e < 8; ++e) { const float s = fsigmoid(v[e]); v[e] = flog(lb[bj][e] + (1.0f - lb[bj][e]) * s); }
                    } else if (grp == 4) {
#pragma unroll
                        for (int e = 0; e < 8; ++e) v[e] *= QSCALE;
                    } else if (grp == 7) {
#pragma unroll
                        for (int e = 0; e < 8; ++e) v[e] = fsigmoid(v[e]);
                    }
                    if (grp == 1) { float* p = (float*)ob + roff + bj * HALF; *(f32x4*)p = (f32x4){v[0], v[1], v[2], v[3]}; *(f32x4*)(p + 4) = (f32x4){v[4], v[5], v[6], v[7]}; }
                    else { u32x4 w; w[0] = pk2(v[0], v[1]); w[1] = pk2(v[2], v[3]); w[2] = pk2(v[4], v[5]); w[3] = pk2(v[6], v[7]); *(u32x4*)((bf16*)ob + roff + bj * HALF) = w; }
                }
            }
    }
};

struct InProjOrder {
    StaticOrder a; int G, c;
    __device__ __forceinline__ void init(int G_, int c_) { a.init(33 * BM, N_INP, G_, c_); G = G_; c = c_; }
    __device__ __forceinline__ bool next(int i, Unit& u) const {
        const int L = i * G + c;
        if (L >= 1536 + 192) return false;
        int pm, pn; a.map(L < a.nwg ? L : 0, pm, pn);
        if (L < a.nwg) { u = Unit{pm, pn, 0, 0, -1}; return true; }
        if (L < 1536) { const int r = L - a.nwg; u = Unit{33 + r / 28, r % 28, 0, 0, -1}; return true; }
        const int s = L - 1536, ks = s & 3, tile = s >> 2; u = Unit{33 + tile / 16, 28 + tile % 16, 8 * ks, 8, ks}; return true;
    }
    __device__ __forceinline__ void a_ready(const Unit&) const {}
    __device__ __forceinline__ void done(const Unit&) const {}
};
template <int MODE> struct EpiMix {
    static constexpr bool PERM = true, AFTER_DRAIN = false, MID = false;
    const bf16* G; float* T1; bf16* O; int ld;
    DI void operator()(const f32x4 (&acc)[2][2][4][2], const Unit& u, int wr, int wc, int fr, int fq) const {
        const int row0 = u.pm * BM + wr * 64 + fr, col0 = u.pn * BM + wc * 32 + 8 * fq;
#pragma unroll
        for (int ai = 0; ai < 2; ++ai)
#pragma unroll
            for (int m = 0; m < 4; ++m) {
                const int r = row0 + ai * HALF + m * 16;
#pragma unroll
                for (int bj = 0; bj < 2; ++bj) {
                    const int c = col0 + bj * HALF;
                    float v[8];
#pragma unroll
                    for (int e = 0; e < 4; ++e) { v[e] = acc[ai][bj][m][0][e]; v[4 + e] = acc[ai][bj][m][1][e]; }
                    if (MODE == 0) {
                        float g[8]; unpack8(*(const u32x4*)(G + (size_t)r * 4096 + c), g);
                        float* t = T1 + (size_t)r * 2048 + c;
                        *(f32x4*)t = (f32x4){v[0] * g[0], v[1] * g[1], v[2] * g[2], v[3] * g[3]}; *(f32x4*)(t + 4) = (f32x4){v[4] * g[4], v[5] * g[5], v[6] * g[6], v[7] * g[7]};
                    } else if (MODE == 1) {
                        float g[8]; unpack8(*(const u32x4*)(G + (size_t)r * 4096 + 2048 + c), g);
                        const float* t = T1 + (size_t)r * 2048 + c; const f32x4 t0 = *(const f32x4*)t, t1 = *(const f32x4*)(t + 4);
                        u32x4 w; w[0] = pk2(t0[0] + v[0] * g[0], t0[1] + v[1] * g[1]); w[1] = pk2(t0[2] + v[2] * g[2], t0[3] + v[3] * g[3]);
                        w[2] = pk2(t1[0] + v[4] * g[4], t1[1] + v[5] * g[5]); w[3] = pk2(t1[2] + v[6] * g[6], t1[3] + v[7] * g[7]);
                        *(u32x4*)(O + (size_t)r * 2048 + c) = w;
                    } else {
                        const float rs2 = 1.0f / (T1[r] * (1.0f / D_MODEL) + EPS);
#pragma unroll
                        for (int e = 0; e < 8; ++e) { const float t = fmaxf(v[e], 0.f); v[e] = t * t * rs2; }
                        u32x4 w; w[0] = pk2(v[0], v[1]); w[1] = pk2(v[2], v[3]); w[2] = pk2(v[4], v[5]); w[3] = pk2(v[6], v[7]);
                        *(u32x4*)(O + (size_t)r * ld + c) = w;
                    }
                }
            }
    }
};

struct EpiMerge {
    static constexpr bool PERM = true, AFTER_DRAIN = false, MID = true;
    const bf16* G; bf16* MG; float* slab;
    DI int tmid(const Unit& u) const { return (u.ks < 0) ? (W1K / BK) : -1; }
    DI void mid(f32x4 (&acc)[2][2][4][2], const Unit& u0, int wr, int wc, int fr, int fq) const {
        Unit u = u0; asm volatile("" : "+s"(u.pm), "+s"(u.pn));
        { int ln; asm volatile("v_mbcnt_lo_u32_b32 %0, -1, 0\n\tv_mbcnt_hi_u32_b32 %0, -1, %0" : "=v"(ln)); fr = ln & 15; fq = ln >> 4; }
        const int row0 = u.pm * BM + wr * 64 + fr, col0 = u.pn * BM + wc * 32 + 8 * fq;
#pragma unroll
        for (int ai = 0; ai < 2; ++ai)
#pragma unroll
            for (int m = 0; m < 4; ++m) { const bf16* gr = G + (size_t)(row0 + ai * HALF + m * 16) * 4096 + col0;
#pragma unroll
                for (int bj = 0; bj < 2; ++bj) { float ga[8], gb[8]; unpack8(*(const u32x4*)(gr + bj * HALF), ga); unpack8(*(const u32x4*)(gr + 2048 + bj * HALF), gb);
#pragma unroll
                    for (int e = 0; e < 4; ++e) { acc[ai][bj][m][0][e] *= ga[e] * frcp(fmaxf(gb[e], 1e-30f)); acc[ai][bj][m][1][e] *= ga[4 + e] * frcp(fmaxf(gb[4 + e], 1e-30f)); } } }
    }
    DI void operator()(const f32x4 (&acc)[2][2][4][2], const Unit& u0, int wr, int wc, int fr, int fq) const {
        Unit u = u0; asm volatile("" : "+s"(u.pm), "+s"(u.pn));
        { int ln; asm volatile("v_mbcnt_lo_u32_b32 %0, -1, 0\n\tv_mbcnt_hi_u32_b32 %0, -1, %0" : "=v"(ln)); fr = ln & 15; fq = ln >> 4; }
        const int row0 = u.pm * BM + wr * 64 + fr, col0 = u.pn * BM + wc * 32 + 8 * fq;
        const int goff = (u.ks >= 0 && u.ks < 4) ? 0 : 2048;
        float* sl = slab + (size_t)(u.ks < 0 ? 0 : u.ks) * ((size_t)MS * 2048) - (size_t)MP * 2048;
#pragma unroll
        for (int ai = 0; ai < 2; ++ai)
#pragma unroll
            for (int m = 0; m < 4; ++m) { const int r = row0 + ai * HALF + m * 16;
#pragma unroll
                for (int bj = 0; bj < 2; ++bj) { const int c = col0 + bj * HALF;
                    float g[8]; unpack8(*(const u32x4*)(G + (size_t)r * 4096 + goff + c), g);
                    float v[8];
#pragma unroll
                    for (int e = 0; e < 4; ++e) { v[e] = acc[ai][bj][m][0][e] * g[e]; v[4 + e] = acc[ai][bj][m][1][e] * g[4 + e]; }
                    if (u.ks < 0) { u32x4 w; w[0] = pk2(v[0], v[1]); w[1] = pk2(v[2], v[3]); w[2] = pk2(v[4], v[5]); w[3] = pk2(v[6], v[7]); *(u32x4*)(MG + (size_t)r * 2048 + c) = w; }
                    else { float* t = sl + (size_t)r * 2048 + c; *(f32x4*)t = (f32x4){v[0], v[1], v[2], v[3]}; *(f32x4*)(t + 4) = (f32x4){v[4], v[5], v[6], v[7]}; }
                } }
    }
};

struct SplitOrder {
    StaticOrder full; int nN, KT, KS;
    __device__ __forceinline__ void init(int N, int K, int G, int c, int KS_) { full.init(MP, N, G, c); nN = N / BM; KT = K / BK; KS = KS_; }
    __device__ __forceinline__ bool next(int i, Unit& u) const {
        const int L = i * full.G + full.c, nsp = (MS / BM) * nN * KS;
        if (L >= full.nwg + nsp) return false;
        const bool isfull = L < full.nwg;
        int pmf, pnf; full.map(isfull ? L : 0, pmf, pnf);
        const int s = isfull ? 0 : L - full.nwg, ks = s % KS, tile = s / KS, ntk = KT / KS;
        u = Unit{isfull ? pmf : MP / BM + tile / nN, isfull ? pnf : tile % nN, isfull ? 0 : ks * ntk, isfull ? 0 : ntk, isfull ? -1 : ks};
        return true;
    }
    __device__ __forceinline__ void a_ready(const Unit&) const {}
    __device__ __forceinline__ void done(const Unit&) const {}
};
template <bool XB> struct EpiResid {
    static constexpr bool PERM = false, AFTER_DRAIN = false, MID = false;
    const float* base; float* out; float* slab; bf16* xb; float* sumsq;
    DI void operator()(const f32x4 (&acc)[2][2][4][2], const Unit& u, int wr, int wc, int fr, int fq) const {
        const int row0 = u.pm * BM + wr * 64 + fr, col0 = u.pn * BM + wc * 32 + 4 * fq;
        if (u.ks < 0) {
#pragma unroll
            for (int ai = 0; ai < 2; ++ai)
#pragma unroll
                for (int m = 0; m < 4; ++m) { const int r = row0 + ai * HALF + m * 16; const size_t off = (size_t)r * 2048 + col0; float ss = 0.f;
#pragma unroll
                    for (int bj = 0; bj < 2; ++bj)
#pragma unroll
                        for (int n = 0; n < 2; ++n) { const f32x4 b = *(const f32x4*)(base + off + bj * HALF + n * 16); const f32x4 v = b + acc[ai][bj][m][n]; *(f32x4*)(out + off + bj * HALF + n * 16) = v;
                            if (XB) { *(u32x2*)(xb + off + bj * HALF + n * 16) = (u32x2){pk2(v[0], v[1]), pk2(v[2], v[3])}; ss += (v[0] * v[0] + v[1] * v[1]) + (v[2] * v[2] + v[3] * v[3]); } }
                    if (XB) { ss += __shfl_xor(ss, 16); ss += __shfl_xor(ss, 32); if (fq == 0) sumsq[(size_t)r * 32 + u.pn * 4 + wc] = ss; } }
        } else {
            float* sl = slab + (size_t)u.ks * ((size_t)MS * 2048) - (size_t)MP * 2048;
#pragma unroll
            for (int ai = 0; ai < 2; ++ai)
#pragma unroll
                for (int m = 0; m < 4; ++m) { const size_t off = (size_t)(row0 + ai * HALF + m * 16) * 2048 + col0;
#pragma unroll
                    for (int bj = 0; bj < 2; ++bj)
#pragma unroll
                        for (int n = 0; n < 2; ++n) *(f32x4*)(sl + off + bj * HALF + n * 16) = acc[ai][bj][m][n]; }
        }
    }
};
}
#define XB_TMO      128
#define XB_XCNT(j)  (256  + 64 * (j))
#define XB_XSUB(j)  (1280 + 64 * (j))
#define XB_XGEN(j)  (2304 + 64 * (j))
#define XB_TOP      3328
#define XB_TOPGEN   3392
#define XCD_BAR_WORDS 3456
#define XB_SPIN_CAP (1u << 18)

__device__ __forceinline__ unsigned xb_ld(unsigned* p)              { return __hip_atomic_load(p, __ATOMIC_RELAXED, __HIP_MEMORY_SCOPE_AGENT); }
__device__ __forceinline__ unsigned xb_add(unsigned* p, unsigned v) { return __hip_atomic_fetch_add(p, v, __ATOMIC_RELAXED, __HIP_MEMORY_SCOPE_AGENT); }
__device__ __forceinline__ unsigned xb_xcc_id() { return (unsigned)__builtin_amdgcn_s_getreg((3 << 11) | 20) & 0xFu; }
#define XB_SPIN(cond, bar) do { unsigned _sp = 0; while (cond) { __builtin_amdgcn_s_sleep(1); \
    if ((++_sp & 255u) == 0u) { if (xb_ld(&(bar)[XB_TMO])) break; if (_sp > XB_SPIN_CAP) { atomicAdd(&(bar)[XB_TMO], 1u); break; } } } } while (0)

struct XcdBarrier {
    unsigned* bar; unsigned x;
    volatile LAS unsigned* st;
};

__device__ __forceinline__ XcdBarrier xcd_barrier_post(unsigned* bar, volatile LAS unsigned* st) {
    XcdBarrier b; b.bar = bar; b.x = xb_xcc_id(); b.st = st;
    if (threadIdx.x == 0) (void)xb_add(&bar[XB_XCNT(b.x)], 1u);
    return b;
}
__device__ __forceinline__ void xcd_barrier_complete(unsigned* bar, unsigned x, unsigned& nloc, unsigned& nx) {
    const unsigned G = gridDim.x * gridDim.y * gridDim.z;
    unsigned sum, cnt, mine, sp = 0u;
    for (;;) {
        sum = 0u; cnt = 0u; mine = 0u;
#pragma unroll
        for (unsigned j = 0; j < 16; ++j) { const unsigned c = xb_ld(&bar[XB_XCNT(j)]); sum += c; cnt += (c > 0u) ? 1u : 0u; mine = (j == x) ? c : mine; }
        if (sum == G) break;
        __builtin_amdgcn_s_sleep(1);
        if ((++sp & 255u) == 0u) { if (xb_ld(&bar[XB_TMO])) break; if (sp > XB_SPIN_CAP) { atomicAdd(&bar[XB_TMO], 1u); break; } }
    }
    nloc = mine > 0u ? mine : 1u; nx = cnt > 0u ? cnt : 1u;
}

__device__ __forceinline__ void xcd_barrier(const XcdBarrier& b) {
    asm volatile("s_waitcnt vmcnt(0)" ::: "memory");
    __syncthreads();
    if (threadIdx.x == 0) {
        unsigned* bar = b.bar;
        __builtin_amdgcn_s_waitcnt(0);
        unsigned nloc = b.st[0], nx = b.st[1];
        if (nloc == 0u) { xcd_barrier_complete(bar, b.x, nloc, nx); b.st[0] = nloc; b.st[1] = nx; }
        const unsigned old = xb_add(&bar[XB_XSUB(b.x)], 1u);
        const unsigned gen = old / nloc;
        if (old + 1u == (gen + 1u) * nloc) {
            __builtin_amdgcn_fence(__ATOMIC_RELEASE, "agent");
            asm volatile("s_waitcnt vmcnt(0)" ::: "memory");
            const unsigned og = xb_add(&bar[XB_TOP], 1u);
            const unsigned tg = og / nx;
            if (og + 1u == (tg + 1u) * nx) xb_add(&bar[XB_TOPGEN], 1u);
            else XB_SPIN(xb_ld(&bar[XB_TOPGEN]) == tg, bar);
            __builtin_amdgcn_fence(__ATOMIC_ACQUIRE, "agent");
            xb_add(&bar[XB_XGEN(b.x)], 1u);
            asm volatile("s_waitcnt vmcnt(0)" ::: "memory");
        } else {
            XB_SPIN(xb_ld(&bar[XB_XGEN(b.x)]) == gen, bar);
            __builtin_amdgcn_fence(__ATOMIC_ACQUIRE, "agent");
            asm volatile("s_waitcnt vmcnt(0)" ::: "memory");
        }
    }
    __syncthreads();
}


struct Frame {
    LAS uchar* lds;
    int tid, lane, wave, G, bid;
    const float *x_p, *x_s, *ck, *cv, *clf, *st0, *norm1, *w_in, *b_fox, *lb_logits, *gnorm, *w_pa, *w_pb, *w_o, *norm2, *w1, *w2, *norm_f;
    float* out; uchar* ws;
};
template <class T> DI T* wsp(const Frame& F, size_t off) { return (T*)(F.ws + off); }
DI const float* xrow(const Frame& F, int row) { return row < MP ? F.x_p + (size_t)row * D_MODEL : F.x_s + (size_t)(row - MP) * D_MODEL; }

DI void p0_transpose_item(const float* W, int ldw, int ldt, bf16* WT, int nblk, int shift_from, int shift, LAS uchar* img, const FragAddr& fa, int item, int lane, const float* kscale = nullptr) {
    const int kb = item / nblk, nb = item % nblk, k0 = 64 * kb, n0 = 64 * nb, n0s = n0 + (n0 >= shift_from ? shift : 0);
    const float* src = W + (size_t)(k0 + (lane >> 4)) * ldw + n0s + 4 * (lane & 15);
    f32x4 r[16];
#pragma unroll
    for (int i = 0; i < 16; ++i) r[i] = *(const f32x4*)(src + (size_t)(4 * i) * ldw);
    if (kscale) {
#pragma unroll
        for (int i = 0; i < 16; ++i) r[i] = r[i] * kscale[k0 + 4 * i + (lane >> 4)]; }
#pragma unroll
    for (int i = 0; i < 16; ++i) *(LAS u32x2*)(img + off_a((unsigned)(4 * i + (lane >> 4)), (unsigned)((lane & 15) >> 1)) + 8 * (lane & 1)) = (u32x2){pk2(r[i][0], r[i][1]), pk2(r[i][2], r[i][3])};
    bf16* dst = WT + (size_t)(n0 + (lane & 31)) * ldt + k0 + 8 * (lane >> 5);
#pragma unroll
    for (int c = 0; c < 2; ++c)
#pragma unroll
        for (int ks = 0; ks < 4; ++ks) { const bf16x8 v = frag_tr<false>(img, fa, 0, c, ks); *(bf16x8*)(dst + (size_t)(32 * c) * ldt + 16 * ks) = v; }
}
template <bool WITH_FL> DI void rms_row_bf16(const Frame& F, const float* xr, const float* g, bf16* orow, int row) {
    const f32x4* xv = (const f32x4*)xr + F.lane; const f32x4* gv = (const f32x4*)g + F.lane;
    f32x4 v[8]; float s = 0.f;
#pragma unroll
    for (int j = 0; j < 8; ++j) { v[j] = xv[64 * j]; s += (v[j][0] * v[j][0] + v[j][1] * v[j][1]) + (v[j][2] * v[j][2] + v[j][3] * v[j][3]); }
    const float rstd = 1.0f / sqrtf(wave_sum(s) * (1.0f / D_MODEL) + EPS);
    u32x2* o8 = (u32x2*)orow + F.lane;
#pragma unroll
    for (int j = 0; j < 8; ++j) { v[j] = v[j] * rstd * gv[64 * j]; o8[64 * j] = (u32x2){pk2(v[j][0], v[j][1]), pk2(v[j][2], v[j][3])}; }
    if (WITH_FL) {
        float mine = 0.f;
#pragma unroll
        for (int c = 0; c < 8; ++c) {
            float a = 0.f;
#pragma unroll
            for (int j = 0; j < 8; ++j) { const f32x4 w = *((const LAS f32x4*)(F.lds + RING_OFF) + c * 512 + 64 * j + F.lane); a += (v[j][0] * w[0] + v[j][1] * w[1]) + (v[j][2] * w[2] + v[j][3] * w[3]); }
            const float t = wave_sum(a); if (F.lane == c) mine = t;
            asm volatile("" ::: "memory");
        }
        if (F.lane < 8) {
            const float z = mine + F.b_fox[F.lane];
            const float ls = fminf(z, 0.f) - log1pf(expf(-fabsf(z)));
            wsp<float>(F, WS_LFB)[(size_t)row * 8 + F.lane] = ls;
            if (row < MP) F.out[OUT_LFP + (size_t)row * 8 + F.lane] = ls; else F.out[OUT_LFS + (size_t)(row - MP) * 8 + F.lane] = ls;
        }
    }
}
DI void p0_prologue(const Frame& F) {
    LAS uchar* img = F.lds + RING_OFF + F.wave * 16384;
    const FragAddr fa = make_frag_addr(F.lane);
    const int gw = F.bid * NWAVES + F.wave, NGW = F.G * NWAVES;
    { const int gid = F.bid * 512 + F.tid; if (gid < W1K) { const float a = F.lb_logits[gid], b = F.lb_logits[W1K + gid]; wsp<float>(F, WS_LB)[gid] = 1.0f / (1.0f + expf(b - a)); } }
    for (int idx = F.tid; idx < D_MODEL * 2; idx += NWAVES * 64) { const int k = idx >> 1, hf = idx & 1; const f32x4 w = *(const f32x4*)(F.w_in + (size_t)k * N_IN + COL_FL + 4 * hf);
        LAS float* t = (LAS float*)(F.lds + RING_OFF) + (4 * hf) * D_MODEL + k; t[0] = w[0]; t[D_MODEL] = w[1]; t[2 * D_MODEL] = w[2]; t[3 * D_MODEL] = w[3]; }
    __syncthreads();
    for (int m = gw; m < MROWS; m += NGW) rms_row_bf16<true>(F, xrow(F, m), F.norm1, wsp<bf16>(F, WS_H) + (size_t)m * D_MODEL, m);
    __syncthreads();
    constexpr int I_IN = (D_MODEL / 64) * (N_INP / 64), I_PA = (W1K / 64) * (D_MODEL / 64), I_O = (D_MODEL / 64) * (D_MODEL / 64), I_1 = (D_MODEL / 64) * (D_FF / 64), I_2 = (D_FF / 64) * (D_MODEL / 64);
    constexpr int NITEMS = I_IN + 2 * I_PA + I_O + I_1 + I_2;
    for (int it = gw; it < NITEMS; it += NGW) {
        int r = it;
        if (r < I_IN) { p0_transpose_item(F.w_in, N_IN, D_MODEL, wsp<bf16>(F, WS_WIN), N_INP / 64, COL_FL, 8, img, fa, r, F.lane); continue; } r -= I_IN;
        if (r < I_PA) { p0_transpose_item(F.w_pa, D_MODEL, D_MODEL, wsp<bf16>(F, WS_WP), D_MODEL / 64, 1 << 30, 0, img, fa, r, F.lane); continue; } r -= I_PA;
        if (r < I_PA) { p0_transpose_item(F.w_pb, D_MODEL, D_MODEL, wsp<bf16>(F, WS_WP) + W1K, D_MODEL / 64, 1 << 30, 0, img, fa, r, F.lane); continue; } r -= I_PA;
        if (r < I_O) { p0_transpose_item(F.w_o, D_MODEL, D_MODEL, wsp<bf16>(F, WS_WO), D_MODEL / 64, 1 << 30, 0, img, fa, r, F.lane); continue; } r -= I_O;
        if (r < I_1) { p0_transpose_item(F.w1, D_FF, D_MODEL, wsp<bf16>(F, WS_W1), D_FF / 64, 1 << 30, 0, img, fa, r, F.lane, F.norm2); continue; } r -= I_1;
        p0_transpose_item(F.w2, D_MODEL, D_FF, wsp<bf16>(F, WS_W2), D_MODEL / 64, 1 << 30, 0, img, fa, r, F.lane);
    }
}

DI void scan_rows(const float* src, int n, float (&carry)[8], float* dst, size_t dstride, int j0, int lane) {
    for (int i0 = 0; i0 < n; i0 += 64) {
        const int j = i0 + lane; const bool ok = j < n;
        float v[8];
        { f32x4 a = {0.f, 0.f, 0.f, 0.f}, b = {0.f, 0.f, 0.f, 0.f}; if (ok) { a = *(const f32x4*)(src + (size_t)j * 8); b = *(const f32x4*)(src + (size_t)j * 8 + 4); }
          v[0] = a[0]; v[1] = a[1]; v[2] = a[2]; v[3] = a[3]; v[4] = b[0]; v[5] = b[1]; v[6] = b[2]; v[7] = b[3]; }
#pragma unroll
        for (int h = 0; h < 8; ++h) {
#pragma unroll
            for (int o = 1; o < 64; o <<= 1) { const float t = __shfl_up(v[h], o); if (lane >= o) v[h] += t; }
            v[h] += carry[h];
            carry[h] = __shfl(v[h], 63);
            if (ok) dst[(size_t)h * dstride + j0 + j] = v[h] * LOG2E;
        }
    }
}
DI void sum_rows(const float* src, int n, float (&tot)[8], int lane) {
    float a[8];
#pragma unroll
    for (int h = 0; h < 8; ++h) a[h] = 0.f;
#pragma unroll 1
    for (int j0 = 0; j0 < n; j0 += 512) {
        f32x4 x[8], y[8];
#pragma unroll
        for (int i = 0; i < 8; ++i) { const float* p = src + (size_t)(j0 + 64 * i + lane) * 8; x[i] = *(const f32x4*)p; y[i] = *(const f32x4*)(p + 4); }
#pragma unroll
        for (int i = 0; i < 8; ++i) { a[0] += x[i][0]; a[1] += x[i][1]; a[2] += x[i][2]; a[3] += x[i][3]; a[4] += y[i][0]; a[5] += y[i][1]; a[6] += y[i][2]; a[7] += y[i][3]; }
    }
#pragma unroll
    for (int h = 0; h < 8; ++h) tot[h] = wave_sum(a[h]);
}
DI void scan_seg512(const float* src, float (&carry)[8], float* dst, size_t dstride, int j0, int lane) {
    f32x4 a[8], b[8];
#pragma unroll
    for (int r = 0; r < 8; ++r) { const float* p = src + (size_t)(8 * lane + r) * 8; a[r] = *(const f32x4*)p; b[r] = *(const f32x4*)(p + 4); }
#pragma unroll
    for (int r = 1; r < 8; ++r) { a[r] += a[r - 1]; b[r] += b[r - 1]; }
    float off[8];
#pragma unroll
    for (int h = 0; h < 8; ++h) {
        const float own = (h < 4) ? a[7][h & 3] : b[7][h & 3];
        float inc = own;
#pragma unroll
        for (int o = 1; o < 64; o <<= 1) { const float t = __shfl_up(inc, o); if (lane >= o) inc += t; }
        off[h] = carry[h] + (inc - own);
        carry[h] += __shfl(inc, 63);
    }
#pragma unroll
    for (int h = 0; h < 8; ++h) {
        float* d = dst + (size_t)h * dstride + j0 + 8 * lane;
        f32x4 lo, hi;
#pragma unroll
        for (int r = 0; r < 4; ++r) { lo[r] = (((h < 4) ? a[r][h & 3] : b[r][h & 3]) + off[h]) * LOG2E; hi[r] = (((h < 4) ? a[4 + r][h & 3] : b[4 + r][h & 3]) + off[h]) * LOG2E; }
        *(f32x4*)d = lo; *(f32x4*)(d + 4) = hi;
    }
}
DI void scan_task(const Frame& F, int task) {
    const int sq = task >> 3, seg = task & 7;
    float carry[8];
    const float* lfb = wsp<float>(F, WS_LFB);
    if (sq < NB_P) { const float* src = lfb + (size_t)sq * SEQ * 8;
        sum_rows(src, seg * 512, carry, F.lane);
        scan_seg512(src + (size_t)seg * 512 * 8, carry, wsp<float>(F, WS_C2P) + (size_t)sq * 8 * SEQ, SEQ, seg * 512, F.lane); }
    else { const int b = sq - NB_P; float* dst = wsp<float>(F, WS_C2S) + (size_t)b * 8 * SKV_S; const float* src = F.clf + (size_t)b * PAST * 8;
        sum_rows(src, seg * 512, carry, F.lane);
        scan_seg512(src + (size_t)seg * 512 * 8, carry, dst, SKV_S, seg * 512, F.lane);
        if (seg == 7) scan_rows(lfb + (size_t)(MP + b * T_S) * 8, T_S, carry, dst, SKV_S, PAST, F.lane); }
}
constexpr int N_SCAN_TASKS = (NB_P + NB_S) * 8;
DI void unpack8x(const u32x4 w, float (&f)[8]) { f[0] = bf_lo(w[0]); f[1] = bf_hi(w[0]); f[2] = bf_lo(w[1]); f[3] = bf_hi(w[1]); f[4] = bf_lo(w[2]); f[5] = bf_hi(w[2]); f[6] = bf_lo(w[3]); f[7] = bf_hi(w[3]); }
DI void p_attn_stats(const Frame& F) {
    const int lane = F.lane;
    float* qn = wsp<float>(F, WS_QN); float* md = qn + 16 * SEQ; unsigned* kmax = (unsigned*)(F.ws + WS_CTL) + CW_KMAX;
    LAS float* red = (LAS float*)(F.lds + SCR_OFF);
    for (int r0 = F.bid * 32; r0 < MP; r0 += F.G * 32) {
        float kmx = 0.f;
#pragma unroll
        for (int rr = 0; rr < 4; ++rr) {
            const int row = r0 + 4 * F.wave + rr;
            const size_t o = (size_t)row * W1K + 16 * lane;
            float qv[16], kv[16];
            { float t[8]; unpack8x(*(const u32x4*)(wsp<bf16>(F, WS_QB) + o), t);
#pragma unroll
              for (int e = 0; e < 8; ++e) qv[e] = t[e];
              unpack8x(*(const u32x4*)(wsp<bf16>(F, WS_QB) + o + 8), t);
#pragma unroll
              for (int e = 0; e < 8; ++e) qv[8 + e] = t[e];
              unpack8x(*(const u32x4*)(wsp<bf16>(F, WS_KB) + o), t);
#pragma unroll
              for (int e = 0; e < 8; ++e) kv[e] = t[e];
              unpack8x(*(const u32x4*)(wsp<bf16>(F, WS_KB) + o + 8), t);
#pragma unroll
              for (int e = 0; e < 8; ++e) kv[8 + e] = t[e]; }
            float qq = 0.f, kk = 0.f, qk = 0.f;
#pragma unroll
            for (int e = 0; e < 16; ++e) { qq += qv[e] * qv[e]; kk += kv[e] * kv[e]; qk += qv[e] * kv[e]; }
#pragma unroll
            for (int o2 = 1; o2 < 8; o2 <<= 1) { qq += __shfl_xor(qq, o2); kk += __shfl_xor(kk, o2); qk += __shfl_xor(qk, o2); }
            kmx = fmaxf(kmx, sqrtf(kk));
            if ((lane & 7) == 0) { const int head = lane >> 3, b = row >> 12, t = row & (SEQ - 1), bh = b * NH + head;
                qn[(size_t)bh * SEQ + t] = sqrtf(qq); md[(size_t)bh * SEQ + t] = qk; }
        }
        if ((lane & 7) == 0) red[F.wave * 8 + (lane >> 3)] = kmx;
        __syncthreads();
        if (F.tid < 8) { float v = red[F.tid];
#pragma unroll
            for (int w = 1; w < 8; ++w) v = fmaxf(v, red[w * 8 + F.tid]);
            const int b = r0 >> 12, t = r0 & (SEQ - 1);
            atomicMax(kmax + (b * NH + F.tid) * 32 + (t >> 7), __float_as_uint(v)); }
        __syncthreads();
    }
}
DI void p_combine_gate(const Frame& F) {
    const int gid = F.bid * 512 + F.tid, NT = F.G * 512;
    const float* sl = wsp<float>(F, WS_T1); bf16* G = wsp<bf16>(F, WS_G) + (size_t)(33 * 256) * 4096;
    for (int i = gid; i < 768 * 4096 / 8; i += NT) {
        f32x4 a = *(const f32x4*)(sl + (size_t)i * 8), b = *(const f32x4*)(sl + (size_t)i * 8 + 4);
#pragma unroll
        for (int ks = 1; ks < 4; ++ks) { a += *(const f32x4*)(sl + (size_t)ks * (768u * 4096u) + (size_t)i * 8); b += *(const f32x4*)(sl + (size_t)ks * (768u * 4096u) + (size_t)i * 8 + 4); }
        u32x4 w; w[0] = pk2(fsigmoid(a[0]), fsigmoid(a[1])); w[1] = pk2(fsigmoid(a[2]), fsigmoid(a[3])); w[2] = pk2(fsigmoid(b[0]), fsigmoid(b[1])); w[3] = pk2(fsigmoid(b[2]), fsigmoid(b[3]));
        *(u32x4*)(G + (size_t)i * 8) = w;
    }
}
DI void unit_rc(int u, int& row0, int& head) { if (u < NU_P) { const int bh = u >> 7, c = u & 127; row0 = (bh >> 3) * SEQ + c * CHK; head = bh & 7; } else { const int su = u - NU_P; row0 = MP + (su >> 3) * T_S; head = su & 7; } }
constexpr int HG_QT = 0, HG_KT = 8192, HG_KP = 16384, HG_V = 24576, HG_SP = 32768;
struct HgPre { f32x4 lf[4]; u32x2 q[4]; u32x4 v[2]; };
DI void hgrn_load(const Frame& F, int u, int tl, HgPre& P) {
    int row0, head; unit_rc(u, row0, head);
    const int cg = tl & 31, rg = tl >> 5;
    const size_t o = (size_t)(row0 + 4 * rg) * W1K + head * DH + 4 * cg;
#pragma unroll
    for (int r = 0; r < 4; ++r) { P.lf[r] = *(const f32x4*)(wsp<float>(F, WS_LFA) + o + (size_t)r * W1K); P.q[r] = *(const u32x2*)(wsp<bf16>(F, WS_QA) + o + (size_t)r * W1K); }
#pragma unroll
    for (int i = 0; i < 2; ++i) { const int idx = tl + 256 * i, row = idx >> 4, ch = idx & 15; P.v[i] = *(const u32x4*)(wsp<bf16>(F, WS_VA) + (size_t)(row0 + row) * W1K + head * DH + ch * 8); }
}
DI void hgrn_stage1(HgPre& P, int tl, LAS float* tot) {
    P.lf[1] += P.lf[0]; P.lf[2] += P.lf[1]; P.lf[3] += P.lf[2];
    *(LAS f32x4*)(tot + (tl >> 5) * DH + 4 * (tl & 31)) = P.lf[3];
}
template <bool WRITE_DEC> DI void hgrn_stage2(const Frame& F, int u, int tl, const HgPre& P, LAS uchar* base, const LAS float* tot) {
    const int cg = tl & 31, rg = tl >> 5;
    f32x4 pre = {0.f, 0.f, 0.f, 0.f}, bend = {0.f, 0.f, 0.f, 0.f};
#pragma unroll
    for (int g = 0; g < 8; ++g) { const f32x4 t = *(const LAS f32x4*)(tot + g * DH + 4 * cg); bend += t; if (g < rg) pre += t; }
#pragma unroll
    for (int r = 0; r < 4; ++r) {
        const f32x4 b = pre + P.lf[r];
        const f32x4 lf = (r == 0) ? P.lf[0] : (f32x4)(P.lf[r] - P.lf[r > 0 ? r - 1 : 0]);
        const float q0 = bf_lo(P.q[r][0]), q1 = bf_hi(P.q[r][0]), q2 = bf_lo(P.q[r][1]), q3 = bf_hi(P.q[r][1]);
        float qt[4], kt[4], kp[4];
        const float qq[4] = {q0, q1, q2, q3};
#pragma unroll
        for (int e = 0; e < 4; ++e) { const float k = 1.0f - fexp(lf[e]); qt[e] = qq[e] * fexp(b[e]); kt[e] = k * fexp(-b[e]); kp[e] = k * fexp(bend[e] - b[e]); }
        const unsigned a = off_a((unsigned)(4 * rg + r), (unsigned)(cg >> 1)) + 8u * (cg & 1);
        *(LAS u32x2*)(base + HG_QT + a) = (u32x2){pk2(qt[0], qt[1]), pk2(qt[2], qt[3])};
        *(LAS u32x2*)(base + HG_KT + a) = (u32x2){pk2(kt[0], kt[1]), pk2(kt[2], kt[3])};
        *(LAS u32x2*)(base + HG_KP + a) = (u32x2){pk2(kp[0], kp[1]), pk2(kp[2], kp[3])};
    }
    if (WRITE_DEC && rg == 0) *(f32x4*)(wsp<float>(F, WS_DEC) + (size_t)u * DH + 4 * cg) = (f32x4){fexp(bend[0]), fexp(bend[1]), fexp(bend[2]), fexp(bend[3])};
#pragma unroll
    for (int i = 0; i < 2; ++i) { const int idx = tl + 256 * i, row = idx >> 4, ch = idx & 15; *(LAS u32x4*)(base + HG_V + off_a((unsigned)row, (unsigned)ch)) = P.v[i]; }
}
DI void p3_hgrn_local(const Frame& F) {
    const int hw = F.wave >> 2, wl = F.wave & 3, tl = F.tid & 255, lane = F.lane, h = lane >> 5;
    LAS uchar* base = F.lds + RING_OFF + hw * 65536;
    LAS float* tot = (LAS float*)(F.lds + QIMG_OFF) + hw * (8 * DH);
    const FragAddr fa = make_frag_addr(lane);
    HgPre P;
    int it = F.bid;
    if (it < NU / 2) hgrn_load(F, 2 * it + hw, tl, P);
    for (; it < NU / 2; it += F.G) {
        const int u = 2 * it + hw;
        hgrn_stage1(P, tl, tot);
        __syncthreads();
        hgrn_stage2<true>(F, u, tl, P, base, tot);
        if (it + F.G < NU / 2) hgrn_load(F, 2 * (it + F.G) + hw, tl, P);
        __syncthreads();
        float* ds = wsp<float>(F, WS_DS) + (size_t)u * (DH * DH);
        const int dt = wl;
        const bf16x8 a0 = frag_tr<false>(base + HG_KP, fa, 0, dt, 0), a1 = frag_tr<false>(base + HG_KP, fa, 0, dt, 1);
#pragma unroll
        for (int et = 0; et < 4; ++et) {
            f32x16 acc;
#pragma unroll
            for (int i = 0; i < 16; ++i) acc[i] = 0.f;
            acc = MFMA32(a0, frag_tr<false>(base + HG_V, fa, 0, et, 0), acc);
            acc = MFMA32(a1, frag_tr<false>(base + HG_V, fa, 0, et, 1), acc);
#pragma unroll
            for (int i = 0; i < 16; ++i) { const int d = 32 * dt + (i & 3) + 8 * (i >> 2) + 4 * h; ds[(size_t)d * DH + 32 * et + (lane & 31)] = acc[i]; }
        }
        __syncthreads();
    }
}
DI void p4_hgrn_scan(const Frame& F) {
    const int gid = F.bid * 512 + F.tid, NT = F.G * 512;
    const float* DSb = wsp<float>(F, WS_DS); const float* DEC = wsp<float>(F, WS_DEC); bf16* SP = wsp<bf16>(F, WS_SP);
    for (int ch = gid; ch < NB_P * NH * DH * (DH / 2); ch += NT) {
        const int bh = ch >> 13, d = (ch >> 6) & 127, e = (ch & 63) * 2;
        float s0 = 0.f, s1 = 0.f;
        const size_t eo = (size_t)d * DH + e;
#pragma unroll 1
        for (int c0 = 0; c0 < NCH; c0 += 16) {
            f32x2 dv[16]; float dc[16];
#pragma unroll
            for (int j = 0; j < 16; ++j) { const int u = bh * NCH + c0 + j; dv[j] = *(const f32x2*)(DSb + (size_t)u * (DH * DH) + eo); dc[j] = DEC[(size_t)u * DH + d]; }
#pragma unroll
            for (int j = 0; j < 16; ++j) { const int u = bh * NCH + c0 + j;
                *(unsigned*)(SP + (size_t)u * (DH * DH) + eo) = pk2(s0, s1);
                s0 = s0 * dc[j] + dv[j][0]; s1 = s1 * dc[j] + dv[j][1]; }
        }
        *(f32x2*)(F.out + OUT_SP + (size_t)bh * (DH * DH) + eo) = (f32x2){s0, s1};
    }
    for (int i = gid; i < NU_S * DH * DH / 4; i += NT) {
        const int su = i >> 12, r = i & 4095, d = r >> 5;
        const int u = NU_P + su;
        const f32x4 s0 = *(const f32x4*)(F.st0 + (size_t)i * 4), dv = *(const f32x4*)(DSb + (size_t)u * (DH * DH) + (size_t)r * 4); const float dc = DEC[(size_t)u * DH + d];
        *(f32x4*)(F.out + OUT_SS + (size_t)i * 4) = s0 * dc + dv;
    }
}
DI void p5_hgrn_out(const Frame& F) {
    const int hw = F.wave >> 2, wl = F.wave & 3, tl = F.tid & 255, lane = F.lane, h = lane >> 5, t = lane & 31;
    LAS uchar* base = F.lds + RING_OFF + hw * 65536;
    LAS float* red = (LAS float*)(F.lds + SCR_OFF) + hw * 128;
    LAS float* tot = (LAS float*)(F.lds + QIMG_OFF) + hw * (8 * DH);
    const FragAddr fa = make_frag_addr(lane);
    HgPre P; u32x4 spr[8];
#define HG_LOAD_SP(uu) do { if ((uu) < NU_P) { const bf16* sp_ = wsp<bf16>(F, WS_SP) + (size_t)(uu) * (DH * DH); _Pragma("unroll") for (int i = 0; i < 8; ++i) { const int idx = tl + 256 * i; spr[i] = *(const u32x4*)(sp_ + (size_t)(idx >> 4) * DH + (idx & 15) * 8); } } } while (0)
    int it = F.bid;
    if (it < NU / 2) { hgrn_load(F, 2 * it + hw, tl, P); HG_LOAD_SP(2 * it + hw); }
    for (; it < NU / 2; it += F.G) {
        const int u = 2 * it + hw;
        int row0, head; unit_rc(u, row0, head);
        hgrn_stage1(P, tl, tot);
        __syncthreads();
        hgrn_stage2<false>(F, u, tl, P, base, tot);
        if (u < NU_P) {
#pragma unroll
            for (int i = 0; i < 8; ++i) { const int idx = tl + 256 * i, row = idx >> 4, ch = idx & 15; *(LAS u32x4*)(base + HG_SP + off_a((unsigned)row, (unsigned)ch)) = spr[i]; }
        } else {
            const float* sp = F.st0 + (size_t)(u - NU_P) * (DH * DH);
#pragma unroll
            for (int i = 0; i < 16; ++i) { const int idx = tl + 256 * i, row = idx >> 5, c4 = idx & 31; const f32x4 v = *(const f32x4*)(sp + (size_t)row * DH + c4 * 4);
                *(LAS u32x2*)(base + HG_SP + off_a((unsigned)row, (unsigned)(c4 >> 1)) + 8 * (c4 & 1)) = (u32x2){pk2(v[0], v[1]), pk2(v[2], v[3])}; }
        }
        if (it + F.G < NU / 2) { hgrn_load(F, 2 * (it + F.G) + hw, tl, P); HG_LOAD_SP(2 * (it + F.G) + hw); }
        __syncthreads();
        const int et = wl;
        const bf16* ga = wsp<bf16>(F, WS_GA) + (size_t)(row0 + t) * W1K + head * DH; bf16* oa = wsp<bf16>(F, WS_OAB) + (size_t)(row0 + t) * 2048 + head * DH;
        u32x2 gw2[4];
#pragma unroll
        for (int g = 0; g < 4; ++g) gw2[g] = *(const u32x2*)(ga + 32 * et + 8 * g + 4 * h);
        bf16x8 qf[8];
#pragma unroll
        for (int ks = 0; ks < 8; ++ks) qf[ks] = frag_row(base + HG_QT, fa, 0, ks);
        f32x16 at, o;
#pragma unroll
        for (int i = 0; i < 16; ++i) { at[i] = 0.f; o[i] = 0.f; }
#pragma unroll
        for (int ks = 0; ks < 8; ++ks) at = MFMA32(frag_row(base + HG_KT, fa, 0, ks), qf[ks], at);
#pragma unroll
        for (int i = 0; i < 16; ++i) { const int s = (i & 3) + 8 * (i >> 2) + 4 * h; at[i] = (s <= t) ? at[i] : 0.f; }
#pragma unroll
        for (int ks = 0; ks < 8; ++ks) o = MFMA32(frag_tr<false>(base + HG_SP, fa, 0, et, ks), qf[ks], o);
        o = MFMA32(frag_tr<true>(base + HG_V, fa, 0, et, 0), pack_acc(at, 0), o);
        o = MFMA32(frag_tr<true>(base + HG_V, fa, 0, et, 1), pack_acc(at, 1), o);
        float ss = 0.f;
#pragma unroll
        for (int i = 0; i < 16; ++i) ss += o[i] * o[i];
        ss += __shfl_xor(ss, 32);
        if (h == 0) red[wl * 32 + t] = ss;
        __syncthreads();
        const float totss = (red[t] + red[32 + t]) + (red[64 + t] + red[96 + t]);
        const float rstd = 1.0f / sqrtf(totss * (1.0f / DH) + EPS);
#pragma unroll
        for (int g = 0; g < 4; ++g) {
            const int e0 = 32 * et + 8 * g + 4 * h;
            const f32x4 gn = *(const f32x4*)(F.gnorm + e0);
            const float v0 = o[4 * g + 0] * rstd * gn[0] * bf_lo(gw2[g][0]), v1 = o[4 * g + 1] * rstd * gn[1] * bf_hi(gw2[g][0]), v2 = o[4 * g + 2] * rstd * gn[2] * bf_lo(gw2[g][1]), v3 = o[4 * g + 3] * rstd * gn[3] * bf_hi(gw2[g][1]);
            *(u32x2*)(oa + e0) = (u32x2){pk2(v0, v1), pk2(v2, v3)};
        }
        __syncthreads();
    }
#undef HG_LOAD_SP
}

template <bool QLDS> DI void flash_scores(const bool MASK, const bf16x8 (&qf)[8], LAS uchar* qimg, LAS uchar* kimg, int R0, const f32x4 (&ckv)[4], float cq2, int kabs0, int qabs, f32x16& s, float& mx, int lane, const FragAddr& fa) {
    const int h = lane >> 5;
#pragma unroll
    for (int i = 0; i < 16; ++i) s[i] = 0.f;
#pragma unroll
    for (int ks = 0; ks < 8; ++ks) { s = MFMA32(frag_row(kimg, fa, R0, ks), QLDS ? frag_row(qimg, fa, 0, ks) : qf[ks], s); if (QLDS && (ks & 1)) asm volatile("" ::: "memory"); }
    mx = -INFINITY;
#pragma unroll
    for (int g = 0; g < 4; ++g) {
        const f32x4 ck = ckv[g];
#pragma unroll
        for (int e = 0; e < 4; ++e) {
            float v = s[4 * g + e] + (cq2 - ck[e]);
            if (MASK) { const int key = kabs0 + 8 * g + 4 * h + e; v = (key <= qabs) ? v : -INFINITY; }
            s[4 * g + e] = v; mx = fmaxf(mx, v);
        }
    }
    mx = fmaxf(mx, __shfl_xor(mx, 32));
}
DI bool flash_softmax(f32x16& s, float mx, float& m, float& l, f32x16 (&o)[4], bf16x8& pf0, bf16x8& pf1) {
    if (__all(mx < m - 150.f)) return false;
    if (__any(mx > m)) {
        const float mn = fmaxf(m, mx), alpha = fexp2(m - mn);
        m = mn; l *= alpha;
#pragma unroll
        for (int dt = 0; dt < 4; ++dt) o[dt] = o[dt] * alpha;
    }
    float ps = 0.f;
#pragma unroll
    for (int i = 0; i < 16; ++i) { const float p = fexp2(s[i] - m); s[i] = p; ps += p; }
    l += ps;
    pf0 = pack_acc(s, 0); pf1 = pack_acc(s, 1);
    return true;
}
template <bool QLDS> DI bool flash_qk(const bool MASK, const bf16x8 (&qf)[8], LAS uchar* qimg, LAS uchar* kimg, int R0, const f32x4 (&ckv)[4], float cq2, int kabs0, int qabs, float& m, float& l, f32x16 (&o)[4], bf16x8& pf0, bf16x8& pf1, int lane, const FragAddr& fa) {
    f32x16 s; float mx;
    flash_scores<QLDS>(MASK, qf, qimg, kimg, R0, ckv, cq2, kabs0, qabs, s, mx, lane, fa);
    return flash_softmax(s, mx, m, l, o, pf0, pf1);
}
DI void flash_pv(LAS uchar* vimg, int R0, const bf16x8& pf0, const bf16x8& pf1, f32x16 (&o)[4], const FragAddr& fa) {
#pragma unroll
    for (int dt = 0; dt < 4; ++dt) o[dt] = MFMA32(frag_tr<true>(vimg, fa, R0, dt, 0), pf0, o[dt]);
#pragma unroll
    for (int dt = 0; dt < 4; ++dt) o[dt] = MFMA32(frag_tr<true>(vimg, fa, R0, dt, 1), pf1, o[dt]);
}

DI void attn_prompt_unit(const Frame& F, int bh, int qb) {
    const int lane = F.lane, w = F.wave, wq = w & 3, wk = w >> 2, h = lane >> 5, c = lane & 31, tid = F.tid;
    const int b = bh >> 3, head = bh & 7;
    const FragAddr fa = make_frag_addr(lane);
    const bf16* Qg = wsp<bf16>(F, WS_QB) + (size_t)b * SEQ * W1K + head * DH;
    const bf16* Kg = wsp<bf16>(F, WS_KB) + (size_t)b * SEQ * W1K + head * DH;
    const bf16* Vg = wsp<bf16>(F, WS_VB) + (size_t)b * SEQ * W1K + head * DH;
    const float* c2 = wsp<float>(F, WS_C2P) + (size_t)bh * SEQ;
    const int q0 = qb * 128, qabs = q0 + 32 * wq + c, nit = qb + 1;
    int it_lo;
    { const float* qn = wsp<float>(F, WS_QN) + (size_t)bh * SEQ; const float* mdg = qn + 16 * SEQ;
      float QN = fmaxf(qn[q0 + lane], qn[q0 + 64 + lane]), MD = fminf(mdg[q0 + lane], mdg[q0 + 64 + lane]);
#pragma unroll
      for (int o2 = 1; o2 < 64; o2 <<= 1) { QN = fmaxf(QN, __shfl_xor(QN, o2)); MD = fminf(MD, __shfl_xor(MD, o2)); }
      const int blk = lane < nit ? lane : 0;
      const float kmx = __uint_as_float(((const unsigned*)(F.ws + WS_CTL) + CW_KMAX)[bh * 32 + blk]);
      const float bound = QN * kmx * 1.001f + c2[q0] - c2[blk * 128 + 127];
      const bool active = (lane < nit) && !(bound < MD - 160.f);
      const unsigned long long bal = __ballot(active);
      it_lo = bal ? (int)__builtin_ctzll(bal) : nit - 1;
      if (it_lo > nit - 1) it_lo = nit - 1; }
    bf16x8 qf[8];
#pragma unroll
    for (int ks = 0; ks < 8; ++ks) qf[ks] = *(const bf16x8*)(Qg + (size_t)qabs * W1K + 16 * ks + 8 * h);
    const float cq2 = c2[qabs];
    float m = -1e30f, l = 0.f; f32x16 o[4];
#pragma unroll
    for (int dt = 0; dt < 4; ++dt)
#pragma unroll
        for (int i = 0; i < 16; ++i) o[dt][i] = 0.f;
    u32x4 kr[4], vr[4]; f32x4 cr = {0.f, 0.f, 0.f, 0.f};
#define AP_LOAD(itx) do { _Pragma("unroll") for (int i = 0; i < 4; ++i) { const int idx = tid + 512 * i, key = idx >> 4, ch = idx & 15; const size_t go = (size_t)((itx) * 128 + key) * W1K + ch * 8; \
        kr[i] = *(const u32x4*)(Kg + go); vr[i] = *(const u32x4*)(Vg + go); } if (tid < 32) cr = *(const f32x4*)(c2 + (itx) * 128 + tid * 4); } while (0)
#define AP_WRITE(sx) do { LAS uchar* sb_ = F.lds + RING_OFF + (sx) * 65536; _Pragma("unroll") for (int i = 0; i < 4; ++i) { const int idx = tid + 512 * i, key = idx >> 4, ch = idx & 15; \
        const unsigned a = (unsigned)(key >> 6) * 16384u + off_a((unsigned)(key & 63), (unsigned)ch); *(LAS u32x4*)(sb_ + a) = kr[i]; *(LAS u32x4*)(sb_ + 32768 + a) = vr[i]; } if (tid < 32) *((LAS f32x4*)(F.lds + SCR_OFF + 1024) + (sx) * 32 + tid) = cr; } while (0)
    AP_LOAD(nit - 1); AP_WRITE((nit - 1) & 1);
    __syncthreads();
    for (int it = nit - 1; it >= it_lo; --it) {
        const bool more = it > it_lo;
        if (more) AP_LOAD(it - 1);
        LAS uchar* sb = F.lds + RING_OFF + (it & 1) * 65536;
        LAS uchar* kimg = sb + wk * 16384; LAS uchar* vimg = sb + 32768 + wk * 16384;
        const int kabs0 = it * 128 + wk * 64;
        bf16x8 pf0, pf1;
        const bool diag = (it == nit - 1);
#pragma unroll 1
        for (int R0 = 32; R0 >= 0; R0 -= 32) {
            f32x4 ckv[4];
            { const LAS float* cl = (const LAS float*)(F.lds + SCR_OFF + 1024) + (it & 1) * 128 + wk * 64 + R0 + 4 * h;
#pragma unroll
              for (int g = 0; g < 4; ++g) ckv[g] = *(const LAS f32x4*)(cl + 8 * g); }
            if (flash_qk<false>(diag, qf, nullptr, kimg, R0, ckv, cq2, kabs0 + R0, qabs, m, l, o, pf0, pf1, lane, fa)) flash_pv(vimg, R0, pf0, pf1, o, fa);
        }
        if (more) AP_WRITE((it - 1) & 1);
        __syncthreads();
    }
#undef AP_LOAD
#undef AP_WRITE
    LAS f32x4* xb = (LAS f32x4*)(F.lds + RING_OFF) + wq * (17 * 64);
    if (wk == 1) {
#pragma unroll
        for (int dt = 0; dt < 4; ++dt)
#pragma unroll
            for (int g = 0; g < 4; ++g) xb[(dt * 4 + g) * 64 + lane] = (f32x4){o[dt][4 * g], o[dt][4 * g + 1], o[dt][4 * g + 2], o[dt][4 * g + 3]};
        xb[16 * 64 + lane] = (f32x4){m, l, 0.f, 0.f};
    }
    __syncthreads();
    if (wk == 0) {
        const f32x4 ml = xb[16 * 64 + lane];
        const float mn = fmaxf(m, ml[0]), a0 = fexp2(m - mn), a1 = fexp2(ml[0] - mn);
        float lt = l * a0 + ml[1] * a1;
        lt += __shfl_xor(lt, 32);
        const float inv = 1.0f / lt;
        bf16* og = wsp<bf16>(F, WS_OAB) + (size_t)(b * SEQ + qabs) * 2048 + W1K + head * DH;
#pragma unroll
        for (int dt = 0; dt < 4; ++dt)
#pragma unroll
            for (int g = 0; g < 4; ++g) {
                const f32x4 p = xb[(dt * 4 + g) * 64 + lane];
                const float v0 = (o[dt][4 * g] * a0 + p[0] * a1) * inv, v1 = (o[dt][4 * g + 1] * a0 + p[1] * a1) * inv, v2 = (o[dt][4 * g + 2] * a0 + p[2] * a1) * inv, v3 = (o[dt][4 * g + 3] * a0 + p[3] * a1) * inv;
                *(u32x2*)(og + 32 * dt + 8 * g + 4 * h) = (u32x2){pk2(v0, v1), pk2(v2, v3)};
            }
    }
    __syncthreads();
}
DI void p6_attn_prompt(const Frame& F) {
#pragma unroll 1
    for (int j = 2 * F.bid; j < 2 * NB_P * NH * 16; j += ((j & 1) ? 2 * F.G - 1 : 1)) {
        const int item = j >> 1, bh = item >> 4, p = item & 15;
        attn_prompt_unit(F, bh, (j & 1) ? p : 31 - p);
    }
}

struct TileWr { unsigned tb[4]; };
DI TileWr make_tile_wr(int lane) { TileWr t; const unsigned lrow = lane >> 5, lch = lane & 31, ch = lch >> 1;
#pragma unroll
    for (unsigned k = 0; k < 4; ++k) t.tb[k] = 512u * (ch >> 2) + 64u * lrow + 16u * ((ch & 3u) ^ k) + 8u * (lch & 1u);
    return t; }
DI unsigned tile_wr_off(const TileWr& t, int i) { return t.tb[(i >> 1) & 3] + 2048u * (unsigned)(i >> 2) + 128u * (unsigned)(i & 3); }
DI void cache_tile_to_image(const float* src, LAS uchar* img, int lrow, int lch, const TileWr& tw) {
    const float* p = src + (size_t)lrow * (NH * DH) + lch * 4;
#pragma unroll
    for (int qt = 0; qt < 4; ++qt) {
        f32x4 r[4];
#pragma unroll
        for (int i = 0; i < 4; ++i) r[i] = __builtin_nontemporal_load((const f32x4*)(p + (size_t)(2 * (4 * qt + i)) * (NH * DH)));
#pragma unroll
        for (int i = 0; i < 4; ++i) *(LAS u32x2*)(img + tile_wr_off(tw, 4 * qt + i)) = (u32x2){pk2(r[i][0], r[i][1]), pk2(r[i][2], r[i][3])};
        asm volatile("" ::: "memory");
    }
}
DI void attn_sample_unit(const Frame& F, int su) {
    const int lane = F.lane, w = F.wave;
    const int b = su >> 3, head = su & 7;
    const FragAddr fa = make_frag_addr(lane);
    LAS uchar* kimg = F.lds + RING_OFF + w * 16384; LAS uchar* vimg = kimg + 8192;
    const float* c2 = wsp<float>(F, WS_C2S) + (size_t)su * SKV_S;
    bf16x8 qf[8];
#pragma unroll
    for (int ks = 0; ks < 8; ++ks) qf[ks] = (bf16x8){0, 0, 0, 0, 0, 0, 0, 0};
    LAS uchar* qimg = F.lds + QIMG_OFF;
    { const int row = F.tid >> 4, ch = F.tid & 15;
      *(LAS u32x4*)(qimg + off_a((unsigned)row, (unsigned)ch)) = *(const u32x4*)(wsp<bf16>(F, WS_QB) + (size_t)(MP + b * T_S + row) * W1K + head * DH + ch * 8); }
    __syncthreads();
    const float cq2 = c2[PAST + (lane & 31)];
    float m = -1e30f, l = 0.f; f32x16 o[4];
#pragma unroll
    for (int dt = 0; dt < 4; ++dt)
#pragma unroll
        for (int i = 0; i < 16; ++i) o[dt][i] = 0.f;
    bf16x8 pf0, pf1;
    if (w == 0) {
        const bf16* kg = wsp<bf16>(F, WS_KB) + (size_t)(MP + b * T_S) * W1K + head * DH; const bf16* vg = wsp<bf16>(F, WS_VB) + (size_t)(MP + b * T_S) * W1K + head * DH;
#pragma unroll
        for (int i = 0; i < 8; ++i) { const int idx = lane + 64 * i, row = idx >> 4, ch = idx & 15;
            *(LAS u32x4*)(kimg + off_a((unsigned)row, (unsigned)ch)) = *(const u32x4*)(kg + (size_t)row * W1K + ch * 8);
            *(LAS u32x4*)(vimg + off_a((unsigned)row, (unsigned)ch)) = *(const u32x4*)(vg + (size_t)row * W1K + ch * 8); }
        f32x4 ckv[4];
#pragma unroll
        for (int g = 0; g < 4; ++g) ckv[g] = *(const f32x4*)(c2 + PAST + 8 * g + 4 * (lane >> 5));
        if (flash_qk<true>(true, qf, qimg, kimg, 0, ckv, cq2, 0, lane & 31, m, l, o, pf0, pf1, lane, fa)) flash_pv(vimg, 0, pf0, pf1, o, fa);
    }
    const float* kb = F.ck + ((size_t)b * PAST * NH + head) * DH; const float* vb = F.cv + ((size_t)b * PAST * NH + head) * DH;
    const int lrow = lane >> 5, lch = lane & 31;
    f32x4 kp[16], ckv[4];
    const TileWr tw = make_tile_wr(lane);
#define SA_LOADK(jx) do { _Pragma("unroll") for (int g = 0; g < 4; ++g) ckv[g] = *(const f32x4*)(c2 + 32 * (jx) + 8 * g + 4 * (lane >> 5)); \
        const float* p_ = kb + (size_t)(32 * (jx) + lrow) * (NH * DH) + lch * 4; _Pragma("unroll") for (int i = 0; i < 16; ++i) kp[i] = __builtin_nontemporal_load((const f32x4*)(p_ + (size_t)(2 * i) * (NH * DH))); } while (0)
#define SA_WRITEK() do { _Pragma("unroll") for (int i = 0; i < 16; ++i) *(LAS u32x2*)(kimg + tile_wr_off(tw, i)) = (u32x2){pk2(kp[i][0], kp[i][1]), pk2(kp[i][2], kp[i][3])}; } while (0)
    int jt = PAST / 32 - 1 - w;
    SA_LOADK(jt);
    for (; jt >= 0; jt -= NWAVES) {
        SA_WRITEK();
        f32x16 s; float mx;
        flash_scores<true>(false, qf, qimg, kimg, 0, ckv, cq2, 0, 0, s, mx, lane, fa);
        const int jn = jt - NWAVES;
        if (jn >= 0) SA_LOADK(jn);
        if (flash_softmax(s, mx, m, l, o, pf0, pf1)) {
            cache_tile_to_image(vb + (size_t)(32 * jt) * (NH * DH), vimg, lrow, lch, tw);
            flash_pv(vimg, 0, pf0, pf1, o, fa);
        }
    }
#undef SA_LOADK
#undef SA_WRITEK
    LAS float* ms = (LAS float*)(F.lds + SCR_OFF);
    int c, h;
    { int ln; asm volatile("v_mbcnt_lo_u32_b32 %0, -1, 0\n\tv_mbcnt_hi_u32_b32 %0, -1, %0" : "=v"(ln)); c = ln & 31; h = ln >> 5; }
    const int rowq = MP + b * T_S + c;
    l += __shfl_xor(l, 32);
    if (h == 0) ms[w * 32 + c] = m;
    __syncthreads();
    float mg = ms[c];
#pragma unroll
    for (int j = 1; j < 8; ++j) mg = fmaxf(mg, ms[j * 32 + c]);
    const float a = fexp2(m - mg);
    if (h == 0) ms[256 + w * 32 + c] = l * a;
    LAS uchar* po = F.lds + RING_OFF + w * 16384;
#pragma unroll
    for (int dt = 0; dt < 4; ++dt)
#pragma unroll
        for (int g = 0; g < 4; ++g) { const unsigned chk = (unsigned)(8 * dt + 2 * g + h) ^ (unsigned)c;
            *(LAS f32x4*)(po + c * 512 + chk * 16) = (f32x4){o[dt][4 * g] * a, o[dt][4 * g + 1] * a, o[dt][4 * g + 2] * a, o[dt][4 * g + 3] * a}; }
    __syncthreads();
    float lt = 0.f;
#pragma unroll
    for (int j = 0; j < 8; ++j) lt += ms[256 + j * 32 + c];
    const float inv = 1.0f / lt;
    f32x4 s0 = {0.f, 0.f, 0.f, 0.f}, s1 = {0.f, 0.f, 0.f, 0.f};
#pragma unroll
    for (int j = 0; j < 8; ++j) { const LAS uchar* pj = F.lds + RING_OFF + j * 16384 + c * 512;
        s0 += *(const LAS f32x4*)(pj + (((unsigned)(4 * w + 2 * h) ^ (unsigned)c) * 16)); s1 += *(const LAS f32x4*)(pj + (((unsigned)(4 * w + 2 * h + 1) ^ (unsigned)c) * 16)); }
    s0 = s0 * inv; s1 = s1 * inv;
    u32x4 ow; ow[0] = pk2(s0[0], s0[1]); ow[1] = pk2(s0[2], s0[3]); ow[2] = pk2(s1[0], s1[1]); ow[3] = pk2(s1[2], s1[3]);
    *(u32x4*)(wsp<bf16>(F, WS_OAB) + (size_t)rowq * 2048 + W1K + head * DH + 16 * w + 8 * h) = ow;
    __syncthreads();
}
DI void p6_attn_sample(const Frame& F) { for (int su = F.bid; su < NB_S * NH; su += F.G) attn_sample_unit(F, su); }

DI void slab_row_sum(const Frame& F, const float* res, int srow, f32x4 (&v)[8]) {
    const f32x4* rv = (const f32x4*)res + F.lane;
#pragma unroll
    for (int j = 0; j < 8; ++j) v[j] = rv[64 * j];
#pragma unroll 2
    for (int ks = 0; ks < 8; ++ks) { const f32x4* sv = (const f32x4*)(wsp<float>(F, WS_T1) + ((size_t)ks * MS + srow) * D_MODEL) + F.lane;
#pragma unroll
        for (int j = 0; j < 8; ++j) v[j] += sv[64 * j]; }
}
DI void p_combine_mg(const Frame& F) {
    const int gw = F.bid * NWAVES + F.wave, NGW = F.G * NWAVES;
    for (int m = gw; m < MS; m += NGW) {
        f32x4 v[8];
#pragma unroll
        for (int j = 0; j < 8; ++j) v[j] = (f32x4){0.f, 0.f, 0.f, 0.f};
#pragma unroll 2
        for (int ks = 0; ks < 8; ++ks) { const f32x4* sv = (const f32x4*)(wsp<float>(F, WS_T1) + ((size_t)ks * MS + m) * D_MODEL) + F.lane;
#pragma unroll
            for (int j = 0; j < 8; ++j) v[j] += sv[64 * j]; }
        u32x2* o8 = (u32x2*)(wsp<bf16>(F, WS_MG) + (size_t)(MP + m) * D_MODEL) + F.lane;
#pragma unroll
        for (int j = 0; j < 8; ++j) o8[64 * j] = (u32x2){pk2(v[j][0], v[j][1]), pk2(v[j][2], v[j][3])};
    }
}
DI void p_norm2(const Frame& F) {
    const int gw = F.bid * NWAVES + F.wave, NGW = F.G * NWAVES;
    for (int m = MP + gw; m < MROWS; m += NGW) {
        float* x1r = wsp<float>(F, WS_X1) + (size_t)m * D_MODEL;
        f32x4 v[8];
        slab_row_sum(F, F.x_s + (size_t)(m - MP) * D_MODEL, m - MP, v);
        float s = 0.f;
        u32x2* o8 = (u32x2*)(wsp<bf16>(F, WS_H) + (size_t)m * D_MODEL) + F.lane;
#pragma unroll
        for (int j = 0; j < 8; ++j) { ((f32x4*)x1r + F.lane)[64 * j] = v[j]; o8[64 * j] = (u32x2){pk2(v[j][0], v[j][1]), pk2(v[j][2], v[j][3])};
            s += (v[j][0] * v[j][0] + v[j][1] * v[j][1]) + (v[j][2] * v[j][2] + v[j][3] * v[j][3]); }
        s = wave_sum(s);
        if (F.lane == 0) ((float*)(F.ws + WS_CTL) + CW_SUMSQ)[m] = s;
    }
    for (int r = F.bid * 512 + F.tid; r < MP; r += F.G * 512) {
        const f32x4* p = (const f32x4*)(wsp<float>(F, WS_SSP) + (size_t)r * 32);
        f32x4 a = p[0];
#pragma unroll
        for (int i = 1; i < 8; ++i) a += p[i];
        ((float*)(F.ws + WS_CTL) + CW_SUMSQ)[r] = (a[0] + a[1]) + (a[2] + a[3]);
    }
}
DI void p_norm_final(const Frame& F) {
    const int gw = F.bid * NWAVES + F.wave, NGW = F.G * NWAVES;
    for (int m = gw; m < MROWS; m += NGW) {
        f32x4* xv = (f32x4*)(F.out + OUT_Y + (size_t)m * D_MODEL) + F.lane; const f32x4* gv = (const f32x4*)F.norm_f + F.lane;
        f32x4 v[8]; float s = 0.f;
        if (m < MP) {
#pragma unroll
            for (int j = 0; j < 8; ++j) v[j] = xv[64 * j]; }
        else slab_row_sum(F, wsp<float>(F, WS_X1) + (size_t)m * D_MODEL, m - MP, v);
#pragma unroll
        for (int j = 0; j < 8; ++j) s += (v[j][0] * v[j][0] + v[j][1] * v[j][1]) + (v[j][2] * v[j][2] + v[j][3] * v[j][3]);
        const float rstd = 1.0f / sqrtf(wave_sum(s) * (1.0f / D_MODEL) + EPS);
#pragma unroll
        for (int j = 0; j < 8; ++j) xv[64 * j] = v[j] * rstd * gv[64 * j];
    }
}

constexpr int N_PHASES = 14;
struct Args { const float* in[18]; float* out; uchar* ws; int ph_lo, ph_hi; };
__global__ void __launch_bounds__(NWAVES * 64, 2) fwd_kernel(Args args) {
    extern __shared__ __attribute__((aligned(16))) uchar lds_raw[];
    Frame F;
    F.lds = (LAS uchar*)lds_raw;
    F.tid = threadIdx.x; F.lane = F.tid & 63; F.wave = __builtin_amdgcn_readfirstlane(F.tid >> 6);
    F.G = gridDim.x; F.bid = blockIdx.x;
    F.x_p = args.in[0]; F.x_s = args.in[1]; F.ck = args.in[2]; F.cv = args.in[3]; F.clf = args.in[4]; F.st0 = args.in[5]; F.norm1 = args.in[6]; F.w_in = args.in[7]; F.b_fox = args.in[8];
    F.lb_logits = args.in[9]; F.gnorm = args.in[10]; F.w_pa = args.in[11]; F.w_pb = args.in[12]; F.w_o = args.in[13]; F.norm2 = args.in[14]; F.w1 = args.in[15]; F.w2 = args.in[16]; F.norm_f = args.in[17];
    F.out = args.out; F.ws = args.ws;
    for (int u = F.tid; u < (LDS_BYTES - LDSCTL_OFF) / 4; u += NWAVES * 64) ((LAS unsigned*)(F.lds + LDSCTL_OFF))[u] = 0u;
    __syncthreads();
    const int lo = args.ph_lo, hi = args.ph_hi;
    const bool multi = (hi - lo) > 1;
    XcdBarrier bar; bar.bar = (unsigned*)(F.ws + WS_CTL) + CW_BAR; bar.x = 0; bar.st = nullptr;
    if (multi) bar = xcd_barrier_post((unsigned*)(F.ws + WS_CTL) + CW_BAR, (volatile LAS unsigned*)(F.lds + MISC_OFF) + 8);
#ifndef PH_MASK
#define PH_MASK 0xffffffffu
#endif
#define IN(k) (((PH_MASK >> (k)) & 1u) && lo <= (k) && (k) < hi)
#define SEAM(k) do { if (IN(k) && IN((k) + 1)) xcd_barrier(bar); } while (0)
#ifndef DUP_MASK
#define DUP_MASK 0u
#endif
#define RUNPH(k, ...) if (IN(k)) { __VA_ARGS__ if ((DUP_MASK >> (k)) & 1u) { xcd_barrier(bar); __VA_ARGS__ } }
    LAS uchar* ring = F.lds + RING_OFF;

    RUNPH(0, { p0_prologue(F); }) SEAM(0);
    RUNPH(1, {
        pg8::Gemm g{wsp<bf16>(F, WS_H), wsp<bf16>(F, WS_WIN), MROWS, N_INP, D_MODEL}; pg8::InProjOrder S; S.init(F.G, F.bid);
        pg8::EpiInProj E{F.ws, F.out};
        pg8::gemm_phase<pg8::EpiInProj, pg8::InProjOrder, true, true>(ring, g, S, E);
        if (F.bid >= 192) { const int task = (F.bid - 192) * NWAVES + F.wave; if (task < N_SCAN_TASKS) scan_task(F, task); }
    }) SEAM(1);
    RUNPH(2, { p_combine_gate(F); p_attn_stats(F); p3_hgrn_local(F); }) SEAM(2);
    RUNPH(3, { p4_hgrn_scan(F); }) SEAM(3);
    RUNPH(4, { if ((F.bid >> 3) & 1) { p6_attn_prompt(F); p6_attn_sample(F); p5_hgrn_out(F); } else { p6_attn_sample(F); p5_hgrn_out(F); p6_attn_prompt(F); } }) SEAM(4);
    RUNPH(7, {
        pg8::Gemm g{wsp<bf16>(F, WS_OAB), wsp<bf16>(F, WS_WP), MROWS, D_MODEL, D_MODEL}; pg8::SplitOrder S; S.init(D_MODEL, D_MODEL, F.G, F.bid, 8);
        pg8::EpiMerge E{wsp<bf16>(F, WS_G), wsp<bf16>(F, WS_MG), wsp<float>(F, WS_T1)};
        pg8::gemm_phase<pg8::EpiMerge, pg8::SplitOrder, true, true>(ring, g, S, E);
    }) SEAM(7);
    RUNPH(8, { p_combine_mg(F); }) SEAM(8);
    RUNPH(9, {
        pg8::Gemm g{wsp<bf16>(F, WS_MG), wsp<bf16>(F, WS_WO), MROWS, D_MODEL, D_MODEL}; pg8::SplitOrder S; S.init(D_MODEL, D_MODEL, F.G, F.bid, 8);
        pg8::EpiResid<true> E{F.x_p, wsp<float>(F, WS_X1), wsp<float>(F, WS_T1), wsp<bf16>(F, WS_H), wsp<float>(F, WS_SSP)};
        pg8::gemm_phase<pg8::EpiResid<true>, pg8::SplitOrder, true, true>(ring, g, S, E);
    }) SEAM(9);
    RUNPH(10, { p_norm2(F); }) SEAM(10);
    RUNPH(11, {
        pg8::Gemm g{wsp<bf16>(F, WS_H), wsp<bf16>(F, WS_W1), MROWS, D_FF, D_MODEL}; pg8::StaticOrder S; S.init(MROWS, D_FF, F.G, F.bid);
        pg8::EpiMix<2> E{nullptr, (float*)(F.ws + WS_CTL) + CW_SUMSQ, wsp<bf16>(F, WS_U), D_FF};
        pg8::gemm_phase<pg8::EpiMix<2>, pg8::StaticOrder, true, true>(ring, g, S, E);
    }) SEAM(11);
    RUNPH(12, {
        pg8::Gemm g{wsp<bf16>(F, WS_U), wsp<bf16>(F, WS_W2), MROWS, D_MODEL, D_FF}; pg8::SplitOrder S; S.init(D_MODEL, D_FF, F.G, F.bid, 8);
        pg8::EpiResid<false> E{wsp<float>(F, WS_X1), F.out + OUT_Y, wsp<float>(F, WS_T1), nullptr, nullptr};
        pg8::gemm_phase<pg8::EpiResid<false>, pg8::SplitOrder, true, true>(ring, g, S, E);
    }) SEAM(12);
    RUNPH(13, { p_norm_final(F); })
#undef IN
#undef SEAM
}

#ifndef MK_ONE_LAUNCH
#define MK_ONE_LAUNCH 1
#endif
extern "C" void kernel_launch(void* const* d_in, const int* in_sizes, int n_in, void* d_out, int out_size, void* d_ws, size_t ws_size, hipStream_t stream) {
    static int grid = 0;
    if (grid == 0) {
        if (n_in != 18 || (size_t)out_size != OUT_END || ws_size < WS_END) { fprintf(stderr, "kernel_launch: unexpected sizes: n_in %d out %d ws %zu (need out %zu ws %zu)\n", n_in, out_size, ws_size, (size_t)OUT_END, (size_t)WS_END); grid = -1; return; }
        int dev = 0, cus = 0, per_cu = 0;
        if (hipGetDevice(&dev) != hipSuccess || hipDeviceGetAttribute(&cus, hipDeviceAttributeMultiprocessorCount, dev) != hipSuccess) { grid = -1; return; }
        if (hipFuncSetAttribute((const void*)fwd_kernel, hipFuncAttributeMaxDynamicSharedMemorySize, LDS_BYTES) != hipSuccess) { fprintf(stderr, "kernel_launch: hipFuncSetAttribute failed\n"); grid = -1; return; }
        if (hipOccupancyMaxActiveBlocksPerMultiprocessor(&per_cu, (const void*)fwd_kernel, NWAVES * 64, LDS_BYTES) != hipSuccess || per_cu < 1)
            fprintf(stderr, "kernel_launch: note: occupancy query reports %d workgroups per CU\n", per_cu);
        (void)hipGetLastError();
        grid = cus;
    }
    if (grid < 0) return;
    if (hipMemsetAsync((char*)d_ws + WS_CTL, 0, CTL_ZERO_BYTES, stream) != hipSuccess) { fprintf(stderr, "kernel_launch: memset failed\n"); return; }
    Args a{};
    for (int i = 0; i < 18; ++i) a.in[i] = (const float*)d_in[i];
    a.out = (float*)d_out; a.ws = (uchar*)d_ws;
#if MK_ONE_LAUNCH
    a.ph_lo = 0; a.ph_hi = N_PHASES;
    hipLaunchKernelGGL(fwd_kernel, dim3(grid), dim3(NWAVES * 64), LDS_BYTES, stream, a);
#else
    for (int p = 0; p < N_PHASES; ++p) { a.ph_lo = p; a.ph_hi = p + 1; hipLaunchKernelGGL(fwd_kernel, dim3(grid), dim3(NWAVES * 64), LDS_BYTES, stream, a); }
#endif
    const hipError_t le = hipPeekAtLastError();
    if (le != hipSuccess) fprintf(stderr, "kernel_launch: launch failed: %s\n", hipGetErrorName(le));
}
```
